# Optimizing an MI355X kernel written in HIP

```python
import math
import jax, jax.numpy as jnp
from jax import lax
import numpy as np

D_MODEL = 2048
BATCH = 4
SEQ = 2048
DEPTH = 4
DEC_BATCH = 128
DEC_SEQ = 4
PAST_LEN = 16384
PAGE_SIZE = 128

N_MIXERS = 2
N_HG = (DEPTH + 1) // 2
N_GLA = DEPTH // 2
HG_KEY = 128
HG_HEADS = D_MODEL // HG_KEY
HG_VAL = D_MODEL // HG_HEADS
HG_DIM = HG_HEADS * HG_KEY
GLA_HEADS = 4
GLA_KEY_DIM = D_MODEL // 2
GLA_VAL_DIM = D_MODEL
GLA_KEY = GLA_KEY_DIM // GLA_HEADS
GLA_VAL = GLA_VAL_DIM // GLA_HEADS
GLA_RANK = 16
GLA_GATE_NORM = 16.0
GLA_IN = 2 * GLA_KEY_DIM + 2 * GLA_VAL_DIM + GLA_RANK
D_FF = 4 * D_MODEL
CHUNK = 64
ALPHA = (2.0 * DEPTH) ** 0.25
BETA = (8.0 * DEPTH) ** -0.25
EPS = 1e-5

kernel_name = "hgrn2_gla_adaln_deepnorm_step"


def layer_norm(x, w, b):
    xf = x.astype(jnp.float32)
    mu = jnp.mean(xf, -1, keepdims=True)
    xc = xf - mu
    var = jnp.mean(xc * xc, -1, keepdims=True)
    return (xc * lax.rsqrt(var + EPS) * w.astype(jnp.float32) + b.astype(jnp.float32)).astype(x.dtype)


def head_rms_norm(o, w):
    of = o.astype(jnp.float32)
    of = of * lax.rsqrt(jnp.mean(of * of, -1, keepdims=True) + EPS)
    return (of * w.astype(jnp.float32)).astype(o.dtype)


def gated_linear_recurrence(q, k, v, log_f, s0):
    B, T, H, K = q.shape
    V = v.shape[-1]
    C = CHUNK if T % CHUNK == 0 else T
    N = T // C
    f32 = jnp.float32

    def to_chunks(a):
        return a.astype(f32).reshape(B, N, C, H, a.shape[-1]).transpose(1, 0, 3, 2, 4)

    qc, kc, vc, gc = to_chunks(q), to_chunks(k), to_chunks(v), to_chunks(log_f)
    causal = jnp.tril(jnp.ones((C, C), bool))[None, None, :, :, None]

    def step(S, inp):
        qb, kb, vb, gb = inp
        b = jnp.cumsum(gb, axis=2)
        diff = b[:, :, :, None, :] - b[:, :, None, :, :]
        decay = jnp.exp(jnp.where(causal, diff, -jnp.inf))
        att = jnp.einsum('bhtk,bhsk,bhtsk->bhts', qb, kb, decay)
        o = (jnp.einsum('bhts,bhsv->bhtv', att, vb)
             + jnp.einsum('bhtk,bhkv->bhtv', qb * jnp.exp(b), S))
        b_last = b[:, :, -1:, :]
        S_new = (jnp.exp(b_last[:, :, 0, :])[..., None] * S
                 + jnp.einsum('bhsk,bhsv->bhkv', kb * jnp.exp(b_last - b), vb))
        return S_new, o

    S, o = lax.scan(step, s0.astype(f32), (qc, kc, vc, gc))
    o = o.transpose(1, 0, 3, 2, 4).reshape(B, T, H, V)
    return o.astype(q.dtype), S.astype(s0.dtype)


def hgrn2_mixer(h, w_in, lb, norm_w, w_out, s0):
    B, T, _ = h.shape
    q, f_pre, i, g = jnp.split(h @ w_in, 4, axis=-1)
    fp = f_pre.astype(jnp.float32)
    log_f = jnp.logaddexp(jnp.log(lb), jnp.log1p(-lb) + jax.nn.log_sigmoid(fp))
    k = (1.0 - lb) * jax.nn.sigmoid(-fp)
    hd = lambda a, d: a.reshape(B, T, HG_HEADS, d)
    o, s = gated_linear_recurrence(hd(jax.nn.silu(q), HG_KEY), hd(k.astype(h.dtype), HG_KEY),
                                   hd(i, HG_VAL), hd(log_f, HG_KEY), s0)
    o = head_rms_norm(o, norm_w.reshape(HG_HEADS, HG_VAL)).reshape(B, T, HG_DIM) * jax.nn.silu(g)
    return o @ w_out, s


def gla_mixer(h, w_in, w_gk2, b_gk, norm_w, w_out, s0):
    B, T, _ = h.shape
    q, k, v, g, gk_low = jnp.split(
        h @ w_in, np.cumsum([GLA_KEY_DIM, GLA_KEY_DIM, GLA_VAL_DIM, GLA_VAL_DIM]).tolist(), axis=-1)
    log_f = jax.nn.log_sigmoid((gk_low @ w_gk2 + b_gk).astype(jnp.float32)) / GLA_GATE_NORM
    hd = lambda a, d: a.reshape(B, T, GLA_HEADS, d)
    o, s = gated_linear_recurrence(hd(q * GLA_KEY ** -0.5, GLA_KEY), hd(k, GLA_KEY),
                                   hd(v, GLA_VAL), hd(log_f, GLA_KEY), s0)
    o = head_rms_norm(o, norm_w.reshape(GLA_HEADS, GLA_VAL)).reshape(B, T, GLA_VAL_DIM) * jax.nn.silu(g)
    return o @ w_out, s


def trunk(x, c, s_hg, s_gla, w_ada, b_ada, ln_w, ln_b, hg_w_in, hg_lb, hg_norm_w, hg_w_out,
          gla_w_in, gla_w_gk2, gla_b_gk, gla_norm_w, gla_w_out, w_up, w_down):
    new_hg, new_gla = [], []
    cs = jax.nn.silu(c)
    for l in range(DEPTH):
        mod = (cs @ w_ada[l] + b_ada[l])[:, None, :]
        sh1, sc1, g1, sh2, sc2, g2 = jnp.split(mod, 6, axis=-1)
        h = x * (1.0 + sc1) + sh1
        j = l // N_MIXERS
        if l % N_MIXERS == 0:
            y, s = hgrn2_mixer(h, hg_w_in[j], hg_lb[j], hg_norm_w[j], hg_w_out[j], s_hg[j])
            new_hg.append(s)
        else:
            y, s = gla_mixer(h, gla_w_in[j], gla_w_gk2[j], gla_b_gk[j], gla_norm_w[j], gla_w_out[j], s_gla[j])
            new_gla.append(s)
        x = layer_norm(ALPHA * x + (1.0 + g1) * y, ln_w[l, 0], ln_b[l, 0])
        h = x * (1.0 + sc2) + sh2
        y = jnp.square(jax.nn.relu(h @ w_up[l])) @ w_down[l]
        x = layer_norm(ALPHA * x + (1.0 + g2) * y, ln_w[l, 1], ln_b[l, 1])
    return x, jnp.stack(new_hg), jnp.stack(new_gla)


def setup_inputs(seed: int = 0) -> dict:
    key = jax.random.key(seed)
    ks = jax.random.split(key, 32)
    nrm = lambda k, shape, s: jax.random.normal(k, shape, jnp.float32) * s
    d_sc = D_MODEL ** -0.5
    hg_w_in = jnp.concatenate([
        nrm(ks[0], (N_HG, D_MODEL, HG_DIM), d_sc),
        nrm(ks[1], (N_HG, D_MODEL, HG_DIM), d_sc),
        nrm(ks[2], (N_HG, D_MODEL, HG_DIM), d_sc * BETA),
        nrm(ks[3], (N_HG, D_MODEL, HG_DIM), d_sc)], -1)
    gla_w_in = jnp.concatenate([
        nrm(ks[4], (N_GLA, D_MODEL, GLA_KEY_DIM), d_sc),
        nrm(ks[5], (N_GLA, D_MODEL, GLA_KEY_DIM), d_sc),
        nrm(ks[6], (N_GLA, D_MODEL, GLA_VAL_DIM), d_sc * BETA),
        nrm(ks[7], (N_GLA, D_MODEL, GLA_VAL_DIM), d_sc),
        nrm(ks[8], (N_GLA, D_MODEL, GLA_RANK), d_sc)], -1)
    return {
        "x_prompt": nrm(ks[9], (BATCH, SEQ, D_MODEL), 1.0),
        "x_sample": nrm(ks[10], (DEC_BATCH, DEC_SEQ, D_MODEL), 1.0),
        "state_hgrn": nrm(ks[11], (N_HG, DEC_BATCH, HG_HEADS, HG_KEY, HG_VAL), 0.5),
        "state_gla": nrm(ks[12], (N_GLA, DEC_BATCH, GLA_HEADS, GLA_KEY, GLA_VAL), 0.5),
        "c_prompt": nrm(ks[13], (BATCH, D_MODEL), 1.0),
        "c_sample": nrm(ks[14], (DEC_BATCH, D_MODEL), 1.0),
        "w_ada": nrm(ks[15], (DEPTH, D_MODEL, 6 * D_MODEL), d_sc * 0.5),
        "b_ada": nrm(ks[16], (DEPTH, 6 * D_MODEL), 0.02),
        "ln_w": 1.0 + nrm(ks[17], (DEPTH, 2, D_MODEL), 0.02),
        "ln_b": nrm(ks[18], (DEPTH, 2, D_MODEL), 0.02),
        "hg_w_in": hg_w_in,
        "hg_lb_raw": nrm(ks[19], (N_HG, HG_DIM), 0.5),
        "hg_norm_w": 1.0 + nrm(ks[20], (N_HG, HG_DIM), 0.02),
        "hg_w_out": nrm(ks[21], (N_HG, HG_DIM, D_MODEL), HG_DIM ** -0.5 * BETA),
        "gla_w_in": gla_w_in,
        "gla_w_gk2": nrm(ks[22], (N_GLA, GLA_RANK, GLA_KEY_DIM), GLA_RANK ** -0.5),
        "gla_b_gk": nrm(ks[23], (N_GLA, GLA_KEY_DIM), 0.1),
        "gla_norm_w": 1.0 + nrm(ks[24], (N_GLA, GLA_VAL_DIM), 0.02),
        "gla_w_out": nrm(ks[25], (N_GLA, GLA_VAL_DIM, D_MODEL), GLA_VAL_DIM ** -0.5 * BETA),
        "w_up": nrm(ks[26], (DEPTH, D_MODEL, D_FF), d_sc),
        "w_down": nrm(ks[27], (DEPTH, D_FF, D_MODEL), D_FF ** -0.5 * BETA),
    }


def reference(x_prompt, x_sample, state_hgrn, state_gla, c_prompt, c_sample, w_ada, b_ada, ln_w, ln_b,
              hg_w_in, hg_lb_raw, hg_norm_w, hg_w_out, gla_w_in, gla_w_gk2, gla_b_gk, gla_norm_w,
              gla_w_out, w_up, w_down):
    p = jax.nn.softmax(hg_lb_raw.astype(jnp.float32), axis=0)
    hg_lb = jnp.clip(jnp.cumsum(p, axis=0) - p[0], 0.0, 1.0 - 1e-6)
    weights = (w_ada, b_ada, ln_w, ln_b, hg_w_in, hg_lb, hg_norm_w, hg_w_out,
               gla_w_in, gla_w_gk2, gla_b_gk, gla_norm_w, gla_w_out, w_up, w_down)
    zero_hg = jnp.zeros((N_HG, x_prompt.shape[0], HG_HEADS, HG_KEY, HG_VAL), state_hgrn.dtype)
    zero_gla = jnp.zeros((N_GLA, x_prompt.shape[0], GLA_HEADS, GLA_KEY, GLA_VAL), state_gla.dtype)
    y_prompt, new_hgrn_prompt, new_gla_prompt = trunk(x_prompt, c_prompt, zero_hg, zero_gla, *weights)
    y_sample, new_hgrn_sample, new_gla_sample = trunk(x_sample, c_sample, state_hgrn, state_gla, *weights)
    return (y_prompt, y_sample, new_hgrn_prompt, new_gla_prompt, new_hgrn_sample, new_gla_sample)
```

```cpp
#include <hip/hip_runtime.h>
#include <cstdio>
#include <cstdint>
namespace pg8 {
#define PG8_LAS __attribute__((address_space(3)))
typedef unsigned short bf16_t;
typedef short bf16x8 __attribute__((ext_vector_type(8)));
typedef float f32x4 __attribute__((ext_vector_type(4)));
typedef unsigned u32x4 __attribute__((ext_vector_type(4)));
constexpr int BM = 256, BK = 64, HALF = 128, HTB = HALF * BK * 2  , STAGE_BYTES = 8 * HTB, NXCD = 8, WGM = 8;

__host__ __device__ __forceinline__ int lds_byte(int r, int c) { const int st = (r >> 4) * 2 + (c >> 5), rr = r & 15, cc = c & 31, ob = rr * 64 + cc * 2; return st * 1024 + (ob ^ (((ob >> 9) & 1) << 5)); }
__host__ __device__ __forceinline__ void stage_rc(int b, int& R, int& C) { const int st = b / 1024, sb = b % 1024, swz = sb ^ (((sb >> 9) & 1) << 5); R = (st >> 1) * 16 + swz / 64; C = (st & 1) * 32 + (swz % 64) / 2; }
__host__ __device__ __forceinline__ int perm32(int rho) { const int n = rho >> 4, i = rho & 15; return 8 * (i >> 2) + 4 * n + (i & 3); }

struct Unit { int pm, pn; };
struct Gemm { const bf16_t* A; const bf16_t* Bt; int M, N, K; };

struct StaticOrder {
    int nM, nN, nwg, G, c;
    __host__ __device__ void init(int M, int N, int G_, int c_) { nM = M / BM; nN = N / BM; nwg = nM * nN; G = G_; c = c_; }
    __host__ __device__ bool next(int i, Unit& u) const {
        const long L = (long)i * G + c; if (L >= nwg) return false;
        int wgid = (int)L; { const int q = nwg / NXCD, r = nwg % NXCD, xcd = wgid % NXCD, off = wgid / NXCD; wgid = (xcd < r ? xcd * (q + 1) : r * (q + 1) + (xcd - r) * q) + off; }
        const int nig = WGM * nN, gid = wgid / nig, fm = gid * WGM, gsz = (nM - fm) < WGM ? (nM - fm) : WGM;
        u.pm = fm + ((wgid % nig) % gsz); u.pn = (wgid % nig) / gsz; return true;
    }
    __device__ __forceinline__ void a_ready(const Unit&) const {}
    __device__ __forceinline__ void done(const Unit&) const {}
};

__device__ __forceinline__ unsigned cvt_pk_bf16(float lo, float hi) { unsigned r; asm volatile("v_cvt_pk_bf16_f32 %0, %1, %2" : "=v"(r) : "v"(lo), "v"(hi)); return r; }
template <class Epi, class Sched, bool ALIGN_EPI = false, bool SP2 = false>
__device__ __forceinline__ void gemm_phase(PG8_LAS unsigned char* lds, const Gemm g, const Sched& S, const Epi& E) {
    int tid_ = threadIdx.x; asm volatile("" : "+v"(tid_));
    const int tid = tid_, wid = __builtin_amdgcn_readfirstlane(tid >> 6), lane = tid & 63, wr = wid >> 2, wc = wid & 3, fr = lane & 15, fq = lane >> 4;
    const int K = g.K, nt = K / BK;
    unsigned voffA[2], voffB[2];
#pragma unroll
    for (int i = 0; i < 2; ++i) { int R, C; stage_rc(tid * 16 + i * 8192, R, C); const int Rb = Epi::PERM ? ((R & ~31) + perm32(R & 31)) : R;
        voffA[i] = (unsigned)(R * K + C) * 2u; voffB[i] = (unsigned)(Rb * K + C) * 2u; }
    const size_t kstep = (size_t)(BK * 2);
    const size_t hstep = (size_t)HALF * K * 2;
    const size_t tstep = 2 * hstep;
    const unsigned ldsw = (unsigned)wid * 1024u;
    const int aoff = lds_byte(wr * 64 + fr, fq * 8), boff = lds_byte(wc * 32 + fr, fq * 8);
#define PG8_SA(b, h) (((b) * 2 + (h)) * HTB)
#define PG8_SB(b, h) ((4 + (b) * 2 + (h)) * HTB)
#define PG8_STAGE(bufoff, gbase, voff) do { _Pragma("unroll") for (int _i = 0; _i < 2; ++_i) \
        __builtin_amdgcn_global_load_lds((const unsigned*)((const char*)(gbase) + (voff)[_i]), (PG8_LAS unsigned*)(lds + (bufoff) + ldsw + _i * 8192), 16, 0, 0); } while (0)
#define PG8_LDA(dst, b, h) do { _Pragma("unroll") for (int m = 0; m < 4; ++m) _Pragma("unroll") for (int k = 0; k < 2; ++k) dst[m][k] = *(const PG8_LAS bf16x8*)(lds + PG8_SA(b, h) + aoff + m * 2048 + k * 1024); } while (0)
#define PG8_LDB(dst, b, h) do { _Pragma("unroll") for (int n = 0; n < 2; ++n) _Pragma("unroll") for (int k = 0; k < 2; ++k) dst[n][k] = *(const PG8_LAS bf16x8*)(lds + PG8_SB(b, h) + boff + n * 2048 + k * 1024); } while (0)
#define PG8_MMA(ai, bj, At, Bt) do { __builtin_amdgcn_s_setprio(1); _Pragma("unroll") for (int m = 0; m < 4; ++m) _Pragma("unroll") for (int n = 0; n < 2; ++n) _Pragma("unroll") for (int k = 0; k < 2; ++k) \
        acc[ai][bj][m][n] = __builtin_amdgcn_mfma_f32_16x16x32_bf16(Bt[n][k], At[m][k], acc[ai][bj][m][n], 0, 0, 0); __builtin_amdgcn_s_setprio(0); } while (0)
#define PG8_WAIT_V(n) asm volatile("s_waitcnt vmcnt(" #n ")" ::: "memory")
#define PG8_WAIT_L(n) asm volatile("s_waitcnt lgkmcnt(" #n ")" ::: "memory")
#define PG8_BAR __builtin_amdgcn_s_barrier()
#define PG8_SCHED __builtin_amdgcn_sched_barrier(0)
    Unit cur, nxt; int ui = 0;
    if (!S.next(0, cur)) return;
    f32x4 acc[2][2][4][2];
#pragma unroll
    for (int a = 0; a < 2; ++a)
#pragma unroll
        for (int b = 0; b < 2; ++b)
#pragma unroll
            for (int m = 0; m < 4; ++m)
#pragma unroll
                for (int n = 0; n < 2; ++n) acc[a][b][m][n] = (f32x4){0.f, 0.f, 0.f, 0.f};
    bf16x8 At[4][2], B0[2][2], B1[2][2];
    const char* cA = (const char*)g.A + (size_t)cur.pm * tstep; const char* cB = (const char*)g.Bt + (size_t)cur.pn * tstep;
    S.a_ready(cur);
    if constexpr (SP2) {
        PG8_STAGE(PG8_SB(0, 0), cB, voffB); PG8_STAGE(PG8_SB(0, 1), cB + hstep, voffB); PG8_STAGE(PG8_SA(0, 0), cA, voffA); PG8_STAGE(PG8_SA(0, 1), cA + hstep, voffA);
        if (wr == 1) PG8_BAR;
        PG8_WAIT_V(2); PG8_BAR;
        PG8_STAGE(PG8_SB(1, 0), cB + kstep, voffB); PG8_STAGE(PG8_SA(1, 0), cA + kstep, voffA); PG8_STAGE(PG8_SB(1, 1), cB + hstep + kstep, voffB);
        PG8_WAIT_V(6); PG8_BAR;
    } else {
        PG8_STAGE(PG8_SB(0, 0), cB, voffB); PG8_STAGE(PG8_SA(0, 0), cA, voffA); PG8_STAGE(PG8_SB(0, 1), cB + hstep, voffB); PG8_STAGE(PG8_SA(0, 1), cA + hstep, voffA);
        if (wr == 1) PG8_BAR;
        PG8_WAIT_V(4); PG8_BAR;
        PG8_STAGE(PG8_SB(1, 0), cB + kstep, voffB); PG8_STAGE(PG8_SA(1, 0), cA + kstep, voffA); PG8_STAGE(PG8_SB(1, 1), cB + hstep + kstep, voffB);
        PG8_WAIT_V(6); PG8_BAR;
    }
    for (;;) {
        const bool has_next = S.next(ui + 1, nxt);
        const char* nA = has_next ? (const char*)g.A + (size_t)nxt.pm * tstep : cA; const char* nB = has_next ? (const char*)g.Bt + (size_t)nxt.pn * tstep : cB;
        for (int t = 0; t < nt; t += 2) {
            const bool last = (t == nt - 2);
            const char* a1 = cA + (size_t)(t + 1) * kstep;
            const char* a2 = last ? nA : cA + (size_t)(t + 2) * kstep; const char* b2 = last ? nB : cB + (size_t)(t + 2) * kstep;
            const char* a3 = a2 + kstep; const char* b3 = b2 + kstep;
            if (last && has_next) S.a_ready(nxt);
            if constexpr (SP2) {
            PG8_LDB(B0, 0, 0); PG8_LDB(B1, 0, 1); PG8_SCHED; PG8_LDA(At, 0, 0); PG8_STAGE(PG8_SA(1, 1), a1 + hstep, voffA);
            PG8_WAIT_V(8); PG8_WAIT_L(0); PG8_BAR; PG8_MMA(0, 0, At, B0); PG8_MMA(0, 1, At, B1); PG8_BAR; PG8_SCHED;
            PG8_LDA(At, 0, 1); PG8_STAGE(PG8_SB(0, 0), b2, voffB); PG8_STAGE(PG8_SB(0, 1), b2 + hstep, voffB); PG8_STAGE(PG8_SA(0, 0), a2, voffA);
            PG8_WAIT_V(8); PG8_WAIT_L(0); PG8_BAR; PG8_MMA(1, 0, At, B0); PG8_MMA(1, 1, At, B1); PG8_BAR; PG8_SCHED;
            PG8_LDB(B0, 1, 0); PG8_LDB(B1, 1, 1); PG8_SCHED; PG8_LDA(At, 1, 0); PG8_STAGE(PG8_SA(0, 1), a2 + hstep, voffA);
            PG8_WAIT_V(8); PG8_WAIT_L(0); PG8_BAR; PG8_MMA(0, 0, At, B0); PG8_MMA(0, 1, At, B1); PG8_BAR; PG8_SCHED;
            PG8_LDA(At, 1, 1); PG8_STAGE(PG8_SB(1, 0), b3, voffB); PG8_STAGE(PG8_SB(1, 1), b3 + hstep, voffB); PG8_STAGE(PG8_SA(1, 0), a3, voffA);
            PG8_WAIT_V(8); PG8_WAIT_L(0); PG8_BAR; PG8_MMA(1, 0, At, B0); PG8_MMA(1, 1, At, B1); PG8_BAR; PG8_SCHED;
            } else {
            PG8_LDB(B0, 0, 0); PG8_SCHED; PG8_LDA(At, 0, 0); PG8_STAGE(PG8_SA(1, 1), a1 + hstep, voffA);
            PG8_WAIT_L(8); PG8_BAR; PG8_WAIT_L(0); PG8_MMA(0, 0, At, B0); PG8_BAR; PG8_SCHED;
            PG8_LDB(B1, 0, 1); PG8_STAGE(PG8_SB(0, 0), b2, voffB);
            PG8_BAR; PG8_WAIT_L(0); PG8_MMA(0, 1, At, B1); PG8_BAR;
            PG8_LDA(At, 0, 1); PG8_STAGE(PG8_SA(0, 0), a2, voffA);
            PG8_BAR; PG8_WAIT_L(0); PG8_MMA(1, 0, At, B0); PG8_BAR; PG8_SCHED;
            PG8_STAGE(PG8_SB(0, 1), b2 + hstep, voffB);
            PG8_WAIT_V(6); PG8_BAR; PG8_MMA(1, 1, At, B1); PG8_BAR;
            PG8_LDB(B0, 1, 0); PG8_SCHED; PG8_LDA(At, 1, 0); PG8_STAGE(PG8_SA(0, 1), a2 + hstep, voffA);
            PG8_WAIT_L(8); PG8_BAR; PG8_WAIT_L(0); PG8_MMA(0, 0, At, B0); PG8_BAR; PG8_SCHED;
            PG8_LDB(B1, 1, 1); PG8_STAGE(PG8_SB(1, 0), b3, voffB);
            PG8_BAR; PG8_WAIT_L(0); PG8_MMA(0, 1, At, B1); PG8_BAR;
            PG8_LDA(At, 1, 1); PG8_STAGE(PG8_SA(1, 0), a3, voffA);
            PG8_BAR; PG8_WAIT_L(0); PG8_MMA(1, 0, At, B0); PG8_BAR; PG8_SCHED;
            PG8_STAGE(PG8_SB(1, 1), b3 + hstep, voffB);
            PG8_WAIT_V(6); PG8_BAR; PG8_MMA(1, 1, At, B1); PG8_BAR;
            }
        }
        if constexpr (ALIGN_EPI) { if (wr == 0) PG8_BAR; }
        if constexpr (!Epi::AFTER_DRAIN) { E(acc, cur, wr, wc, fr, fq); S.done(cur); }
        if (!has_next) break;
#pragma unroll
        for (int a = 0; a < 2; ++a)
#pragma unroll
            for (int b = 0; b < 2; ++b)
#pragma unroll
                for (int m = 0; m < 4; ++m)
#pragma unroll
                    for (int n = 0; n < 2; ++n) acc[a][b][m][n] = (f32x4){0.f, 0.f, 0.f, 0.f};
        cur = nxt; cA = nA; cB = nB; ++ui;
        if constexpr (ALIGN_EPI) { if (wr == 1) PG8_BAR; }
    }
    PG8_WAIT_V(0);
    if constexpr (!ALIGN_EPI) { if (wr == 0) PG8_BAR; }
    PG8_BAR;
    if constexpr (Epi::AFTER_DRAIN) { E.fused(acc, cur, wr, wc, fr, fq, lds, wid, lane); S.done(cur); }
#undef PG8_SA
#undef PG8_SB
#undef PG8_STAGE
#undef PG8_LDA
#undef PG8_LDB
#undef PG8_MMA
#undef PG8_WAIT_V
#undef PG8_WAIT_L
#undef PG8_BAR
#undef PG8_SCHED
}
}

#ifndef MK_PER_PHASE
#define MK_PER_PHASE 0
#endif

constexpr int D = 2048, MP = 8192, MS = 512, M = MP + MS;
constexpr int SEQ = 2048, NBP = 4, NBS = 128, TS = 4, NCOND = NBP + NBS, DEPTH = 4;
constexpr int DFF = 8192;
constexpr int HG_H = 16, HG_K = 128, HG_V = 128;
constexpr int GL_H = 4, GL_K = 256, GL_V = 512, GL_KD = 1024, GL_R = 16, GL_IN = 6160, GL_INP = 6400;
constexpr int CH = 64, NCH = SEQ / CH;
constexpr float ALPHA = 1.6817928305074290f;
constexpr float LN_EPS = 1e-5f;

constexpr size_t O_YP = 0, O_YS = O_YP + (size_t)MP * D, O_HGP = O_YS + (size_t)MS * D, O_GLP = O_HGP + (size_t)2 * NBP * HG_H * HG_K * HG_V,
                 O_HGS = O_GLP + (size_t)2 * NBP * GL_H * GL_K * GL_V, O_GLS = O_HGS + (size_t)2 * NBS * HG_H * HG_K * HG_V, O_END = O_GLS + (size_t)2 * NBS * GL_H * GL_K * GL_V;

constexpr size_t al(size_t x) { return (x + 4095) & ~(size_t)4095; }
constexpr size_t WS_CTL = 0, CTL_ZERO_BYTES = 1u << 20;
constexpr size_t WS_HGWI = CTL_ZERO_BYTES;
constexpr size_t WS_HGWO = WS_HGWI + (size_t)2 * 8192 * 2048 * 2;
constexpr size_t WS_GLWI = WS_HGWO + (size_t)2 * 2048 * 2048 * 2;
constexpr size_t WS_GLWO = WS_GLWI + (size_t)2 * GL_INP * 2048 * 2;
constexpr size_t WS_WUP  = WS_GLWO + (size_t)2 * 2048 * 2048 * 2;
constexpr size_t WS_WDN  = WS_WUP + (size_t)4 * 8192 * 2048 * 2;
constexpr size_t WS_MOD  = WS_WDN + (size_t)4 * 8192 * 2048 * 2;
constexpr size_t WS_LB   = al(WS_MOD + (size_t)NCOND * 4 * 6 * D * 4);
constexpr size_t WS_CS   = al(WS_LB + (size_t)2 * D * 4);
constexpr size_t WS_X    = al(WS_CS + (size_t)144 * D * 2);
constexpr size_t WS_Z    = WS_X + (size_t)M * D * 4;
constexpr size_t WS_H    = WS_Z + (size_t)M * D * 4;
constexpr size_t WS_O    = WS_H + (size_t)M * D * 2;
constexpr size_t WS_QB   = WS_O + (size_t)M * D * 2;
constexpr size_t WS_KB   = WS_QB + (size_t)M * D * 2;
constexpr size_t WS_VB   = WS_KB + (size_t)M * D * 2;
constexpr size_t WS_GB   = WS_VB + (size_t)M * D * 2;
constexpr size_t WS_LF   = WS_GB + (size_t)M * D * 2;
constexpr size_t WS_U    = WS_LF + (size_t)M * D * 4;
constexpr size_t WS_ST   = WS_U + (size_t)M * DFF * 2;
constexpr size_t WS_END  = WS_ST + (size_t)NBP * GL_H * NCH * GL_V * GL_K * 2;
constexpr int CW_TMO = 0, CW_BAR = 4096;

constexpr int LDS_BYTES = 163840, MISC_OFF = LDS_BYTES - 128;

#define GAS __attribute__((address_space(1)))
#define LAS __attribute__((address_space(3)))
typedef unsigned short bf16;
typedef unsigned v4u __attribute__((ext_vector_type(4)));
typedef unsigned v2u __attribute__((ext_vector_type(2)));
typedef float f32x4 __attribute__((ext_vector_type(4)));
typedef short bf16x8 __attribute__((ext_vector_type(8)));
typedef GAS unsigned gu32;
#define RLX_AGENT __ATOMIC_RELAXED, __HIP_MEMORY_SCOPE_AGENT
#define LDS_WAIT() asm volatile("s_waitcnt lgkmcnt(0)" ::: "memory")
#define VM_WAIT() asm volatile("s_waitcnt vmcnt(0)" ::: "memory")
__device__ __forceinline__ unsigned f2bf(float f) { unsigned u = __builtin_bit_cast(unsigned, f); return (u + 0x7fffu + ((u >> 16) & 1u)) >> 16; }
__device__ __forceinline__ unsigned pk2(float lo, float hi) { return f2bf(lo) | (f2bf(hi) << 16); }
__device__ __forceinline__ float bf2f(unsigned short b) { return __builtin_bit_cast(float, (unsigned)b << 16); }
__device__ __forceinline__ float bflo(unsigned w) { return __builtin_bit_cast(float, w << 16); }
__device__ __forceinline__ float bfhi(unsigned w) { return __builtin_bit_cast(float, w & 0xffff0000u); }
__device__ __forceinline__ float fast_exp(float x) { return __builtin_amdgcn_exp2f(x * 1.4426950408889634f); }
__device__ __forceinline__ float fast_log(float x) { return __builtin_amdgcn_logf(x) * 0.6931471805599453f; }
__device__ __forceinline__ float silu_f(float v) { return v * __builtin_amdgcn_rcpf(1.0f + fast_exp(-v)); }
__device__ __forceinline__ float logsigmoid_f(float x) { return fminf(x, 0.f) - fast_log(1.0f + fast_exp(-fabsf(x))); }
__device__ __forceinline__ float wave_sum(float v) {
#pragma unroll
    for (int o = 1; o < 64; o <<= 1) v += __shfl_xor(v, o);
    return v;
}
__device__ __forceinline__ int cond_of_row(int r) { return r < MP ? (r >> 11) : NBP + ((r - MP) >> 2); }

#define XB_TMO      128
#define XB_XCNT(j)  (256  + 64 * (j))
#define XB_XSUB(j)  (1280 + 64 * (j))
#define XB_XGEN(j)  (2304 + 64 * (j))
#define XB_TOP      3328
#define XB_TOPGEN   3392
#define XCD_BAR_WORDS 3456
#define XB_SPIN_CAP (1u << 18)
#define LAS __attribute__((address_space(3)))

__device__ __forceinline__ unsigned xb_ld(unsigned* p)              { return __hip_atomic_load(p, __ATOMIC_RELAXED, __HIP_MEMORY_SCOPE_AGENT); }
__device__ __forceinline__ unsigned xb_add(unsigned* p, unsigned v) { return __hip_atomic_fetch_add(p, v, __ATOMIC_RELAXED, __HIP_MEMORY_SCOPE_AGENT); }
__device__ __forceinline__ unsigned xb_xcc_id() { return (unsigned)__builtin_amdgcn_s_getreg((3 << 11) | 20) & 0xFu; }
#define XB_SPIN(cond, bar) do { unsigned _sp = 0; while (cond) { __builtin_amdgcn_s_sleep(1); \
    if ((++_sp & 255u) == 0u) { if (xb_ld(&(bar)[XB_TMO])) break; if (_sp > XB_SPIN_CAP) { atomicAdd(&(bar)[XB_TMO], 1u); break; } } } } while (0)

struct XcdBarrier {
    unsigned* bar; unsigned x;
    volatile LAS unsigned* st;
};

__device__ __forceinline__ XcdBarrier xcd_barrier_post(unsigned* bar, volatile LAS unsigned* st) {
    XcdBarrier b; b.bar = bar; b.x = xb_xcc_id(); b.st = st;
    if (threadIdx.x == 0) (void)xb_add(&bar[XB_XCNT(b.x)], 1u);
    return b;
}
__device__ __forceinline__ void xcd_barrier_complete(unsigned* bar, unsigned x, unsigned& nloc, unsigned& nx) {
    const unsigned G = gridDim.x * gridDim.y * gridDim.z;
    unsigned sum, cnt, mine, sp = 0u;
    for (;;) {
        sum = 0u; cnt = 0u; mine = 0u;
#pragma unroll
        for (unsigned j = 0; j < 16; ++j) { const unsigned c = xb_ld(&bar[XB_XCNT(j)]); sum += c; cnt += (c > 0u) ? 1u : 0u; mine = (j == x) ? c : mine; }
        if (sum == G) break;
        __builtin_amdgcn_s_sleep(1);
        if ((++sp & 255u) == 0u) { if (xb_ld(&bar[XB_TMO])) break; if (sp > XB_SPIN_CAP) { atomicAdd(&bar[XB_TMO], 1u); break; } }
    }
    nloc = mine > 0u ? mine : 1u; nx = cnt > 0u ? cnt : 1u;
}

__device__ __forceinline__ void xcd_barrier(const XcdBarrier& b) {
    asm volatile("s_waitcnt vmcnt(0)" ::: "memory");
    __syncthreads();
    if (threadIdx.x == 0) {
        unsigned* bar = b.bar;
        __builtin_amdgcn_s_waitcnt(0);
        unsigned nloc = b.st[0], nx = b.st[1];
        if (nloc == 0u) { xcd_barrier_complete(bar, b.x, nloc, nx); b.st[0] = nloc; b.st[1] = nx; }
        const unsigned old = xb_add(&bar[XB_XSUB(b.x)], 1u);
        const unsigned gen = old / nloc;
        if (old + 1u == (gen + 1u) * nloc) {
            __builtin_amdgcn_fence(__ATOMIC_RELEASE, "agent");
            asm volatile("s_waitcnt vmcnt(0)" ::: "memory");
            const unsigned og = xb_add(&bar[XB_TOP], 1u);
            const unsigned tg = og / nx;
            if (og + 1u == (tg + 1u) * nx) xb_add(&bar[XB_TOPGEN], 1u);
            else XB_SPIN(xb_ld(&bar[XB_TOPGEN]) == tg, bar);
            __builtin_amdgcn_fence(__ATOMIC_ACQUIRE, "agent");
            xb_add(&bar[XB_XGEN(b.x)], 1u);
            asm volatile("s_waitcnt vmcnt(0)" ::: "memory");
        } else {
            XB_SPIN(xb_ld(&bar[XB_XGEN(b.x)]) == gen, bar);
            __builtin_amdgcn_fence(__ATOMIC_ACQUIRE, "agent");
            asm volatile("s_waitcnt vmcnt(0)" ::: "memory");
        }
    }
    __syncthreads();
}

using pg8::cvt_pk_bf16;

struct EpiHgIn {
    static constexpr bool PERM = true, AFTER_DRAIN = false;
    bf16 *QB, *KB, *VB, *GB; float* LF; const float* lb;
    __device__ __forceinline__ void operator()(const pg8::f32x4 (&acc)[2][2][4][2], const pg8::Unit& u, int wr, int wc, int fr, int fq) const {
        const int row0 = u.pm * 256 + wr * 64 + fr, sec = u.pn >> 3, col0 = (u.pn & 7) * 256 + wc * 32 + 8 * fq;
        if (sec == 1) {
#pragma unroll
            for (int bj = 0; bj < 2; ++bj) {
                const int c = col0 + bj * 128;
                const f32x4 l0 = *(const f32x4*)(lb + c), l1 = *(const f32x4*)(lb + c + 4);
#pragma unroll
                for (int ai = 0; ai < 2; ++ai)
#pragma unroll
                    for (int m = 0; m < 4; ++m) {
                        const size_t off = (size_t)(row0 + ai * 128 + m * 16) * D + c;
                        float lf[8], kk[8];
                        const float fpv[8] = {acc[ai][bj][m][0][0], acc[ai][bj][m][0][1], acc[ai][bj][m][0][2], acc[ai][bj][m][0][3], acc[ai][bj][m][1][0], acc[ai][bj][m][1][1], acc[ai][bj][m][1][2], acc[ai][bj][m][1][3]};
                        const float lbs[8] = {l0[0], l0[1], l0[2], l0[3], l1[0], l1[1], l1[2], l1[3]};
#pragma unroll
                        for (int i = 0; i < 8; ++i) {
                            const float fp = fpv[i];
                            const float lbv = lbs[i];
                            const float e = fast_exp(-fabsf(fp)), inv = __builtin_amdgcn_rcpf(1.0f + e);
                            const float sig = fp >= 0.f ? inv : e * inv, nsig = fp >= 0.f ? e * inv : inv;
                            const float ls = fminf(fp, 0.f) - fast_log(1.0f + e);
                            lf[i] = lbv > 0.f ? fast_log(lbv + (1.0f - lbv) * sig) : ls;
                            kk[i] = (1.0f - lbv) * nsig;
                        }
                        *(f32x4*)(LF + off) = (f32x4){lf[0], lf[1], lf[2], lf[3]};
                        *(f32x4*)(LF + off + 4) = (f32x4){lf[4], lf[5], lf[6], lf[7]};
                        v4u w; w.x = cvt_pk_bf16(kk[0], kk[1]); w.y = cvt_pk_bf16(kk[2], kk[3]); w.z = cvt_pk_bf16(kk[4], kk[5]); w.w = cvt_pk_bf16(kk[6], kk[7]);
                        *(v4u*)(KB + off) = w;
                    }
            }
        } else {
            bf16* dst = QB + (size_t)sec * ((size_t)M * D);
            const bool act = sec != 2;
#pragma unroll
            for (int ai = 0; ai < 2; ++ai)
#pragma unroll
                for (int m = 0; m < 4; ++m)
#pragma unroll
                    for (int bj = 0; bj < 2; ++bj) {
                        const size_t off = (size_t)(row0 + ai * 128 + m * 16) * D + col0 + bj * 128;
                        float x[8];
#pragma unroll
                        for (int i = 0; i < 8; ++i) { const float v = (i < 4 ? acc[ai][bj][m][0] : acc[ai][bj][m][1])[i & 3]; x[i] = act ? silu_f(v) : v; }
                        v4u w; w.x = cvt_pk_bf16(x[0], x[1]); w.y = cvt_pk_bf16(x[2], x[3]); w.z = cvt_pk_bf16(x[4], x[5]); w.w = cvt_pk_bf16(x[6], x[7]);
                        *(v4u*)(dst + off) = w;
                    }
        }
    }
};

struct EpiGlaIn {
    static constexpr bool PERM = true, AFTER_DRAIN = false;
    bf16 *QB, *KB, *VB, *GB; float* GKL;
    __device__ __forceinline__ void operator()(const pg8::f32x4 (&acc)[2][2][4][2], const pg8::Unit& u, int wr, int wc, int fr, int fq) const {
        const int row0 = u.pm * 256 + wr * 64 + fr, pn = u.pn;
        if (pn == 24) {
            if (wc == 0 && fq < 2) {
#pragma unroll
                for (int ai = 0; ai < 2; ++ai)
#pragma unroll
                    for (int m = 0; m < 4; ++m) {
                        float* p = GKL + (size_t)(row0 + ai * 128 + m * 16) * GL_R + 8 * fq;
                        *(f32x4*)p = acc[ai][0][m][0]; *(f32x4*)(p + 4) = acc[ai][0][m][1];
                    }
            }
            return;
        }
        int which, ld, colt; float sc = 1.f; bool act = false;
        if (pn < 4) { which = 0; ld = GL_KD; colt = pn * 256; sc = 0.0625f; }
        else if (pn < 8) { which = 1; ld = GL_KD; colt = (pn - 4) * 256; }
        else if (pn < 16) { which = 2; ld = D; colt = (pn - 8) * 256; }
        else { which = 3; ld = D; colt = (pn - 16) * 256; act = true; }
        bf16* dst = QB + (size_t)which * ((size_t)M * D);
        const int col0 = colt + wc * 32 + 8 * fq;
#pragma unroll
        for (int ai = 0; ai < 2; ++ai)
#pragma unroll
            for (int m = 0; m < 4; ++m)
#pragma unroll
                for (int bj = 0; bj < 2; ++bj) {
                    const size_t off = (size_t)(row0 + ai * 128 + m * 16) * ld + col0 + bj * 128;
                    float x[8];
#pragma unroll
                    for (int i = 0; i < 8; ++i) { const float v = (i < 4 ? acc[ai][bj][m][0] : acc[ai][bj][m][1])[i & 3]; x[i] = act ? silu_f(v) : v * sc; }
                    v4u w; w.x = cvt_pk_bf16(x[0], x[1]); w.y = cvt_pk_bf16(x[2], x[3]); w.z = cvt_pk_bf16(x[4], x[5]); w.w = cvt_pk_bf16(x[6], x[7]);
                    *(v4u*)(dst + off) = w;
                }
    }
};

struct EpiUp {
    static constexpr bool PERM = true, AFTER_DRAIN = false;
    bf16* U;
    __device__ __forceinline__ void operator()(const pg8::f32x4 (&acc)[2][2][4][2], const pg8::Unit& u, int wr, int wc, int fr, int fq) const {
        const int row0 = u.pm * 256 + wr * 64 + fr, col0 = u.pn * 256 + wc * 32 + 8 * fq;
#pragma unroll
        for (int ai = 0; ai < 2; ++ai)
#pragma unroll
            for (int m = 0; m < 4; ++m)
#pragma unroll
                for (int bj = 0; bj < 2; ++bj) {
                    const size_t off = (size_t)(row0 + ai * 128 + m * 16) * DFF + col0 + bj * 128;
                    float x[8];
#pragma unroll
                    for (int i = 0; i < 8; ++i) { const float v = fmaxf((i < 4 ? acc[ai][bj][m][0] : acc[ai][bj][m][1])[i & 3], 0.f); x[i] = v * v; }
                    v4u w; w.x = cvt_pk_bf16(x[0], x[1]); w.y = cvt_pk_bf16(x[2], x[3]); w.z = cvt_pk_bf16(x[4], x[5]); w.w = cvt_pk_bf16(x[6], x[7]);
                    *(v4u*)(U + off) = w;
                }
    }
};

struct EpiRes {
    static constexpr bool PERM = false, AFTER_DRAIN = false;
    const float* X; float* Z; const float* gate;
    __device__ __forceinline__ void operator()(const pg8::f32x4 (&acc)[2][2][4][2], const pg8::Unit& u, int wr, int wc, int fr, int fq) const {
        const int row0 = u.pm * 256 + wr * 64 + fr, col0 = u.pn * 256 + wc * 32 + 4 * fq;
#pragma unroll
        for (int ai = 0; ai < 2; ++ai)
#pragma unroll
            for (int m = 0; m < 4; ++m) {
                const int row = row0 + ai * 128 + m * 16;
                const float* g = gate + (size_t)cond_of_row(row) * (4 * 6 * D) + col0;
                const size_t off = (size_t)row * D + col0;
#pragma unroll
                for (int bj = 0; bj < 2; ++bj)
#pragma unroll
                    for (int n = 0; n < 2; ++n) {
                        const f32x4 gv = *(const f32x4*)(g + bj * 128 + n * 16), xv = *(const f32x4*)(X + off + bj * 128 + n * 16);
                        *(f32x4*)(Z + off + bj * 128 + n * 16) = xv * ALPHA + (gv + 1.0f) * acc[ai][bj][m][n];
                    }
            }
    }
};

struct Args { const float* in[21]; float* out; unsigned char* ws; int ph_lo, ph_hi; };
typedef const __attribute__((address_space(4))) Args* KArgs;
struct Frame {
    LAS unsigned char* lds;
    volatile LAS unsigned* MISC;
    int tid, lane, wave;
    int vcu, G, bx;
    unsigned char* ws;
    KArgs ka;
    float* out;
};
constexpr int NWAVES = 8, NT = 512;
__device__ __forceinline__ Frame mk_frame() {
    extern __shared__ __attribute__((aligned(16))) unsigned char lds_base[];
    Frame F;
    int tid = threadIdx.x; asm volatile("" : "+v"(tid));
    int bx = blockIdx.x, G = gridDim.x; asm volatile("" : "+s"(bx), "+s"(G));
    KArgs ka = (KArgs)__builtin_amdgcn_kernarg_segment_ptr(); asm volatile("" : "+s"(ka));
    F.lds = (LAS unsigned char*)lds_base; F.MISC = (volatile LAS unsigned*)(F.lds + MISC_OFF);
    F.tid = tid; F.lane = tid & 63; F.wave = __builtin_amdgcn_readfirstlane(tid >> 6);
    F.G = G; F.bx = bx; F.vcu = (G % 8 == 0) ? (bx % 8) * (G / 8) + bx / 8 : bx;
    F.ka = ka; F.ws = ka->ws; F.out = ka->out;
    return F;
}

__device__ __forceinline__ void p0_transpose_item(const float* W, int K, int ld, int ncols, bf16* WT, LAS float* scr, int item, int lane) {
    const int nblk = ncols / 32, kb = item / nblk, nb = item % nblk, k0 = 64 * kb, n0 = 32 * nb;
#pragma unroll 8
    for (int i = 0; i < 32; ++i) { const int kk = 2 * i + (lane >> 5); scr[kk * 33 + (lane & 31)] = W[(size_t)(k0 + kk) * ld + n0 + (lane & 31)]; }
    LDS_WAIT(); asm volatile("" ::: "memory");
    const int c = lane & 7;
#pragma unroll
    for (int j = 0; j < 4; ++j) { const int n = (lane >> 3) + 8 * j; const LAS float* s = scr + (8 * c) * 33 + n;
        v4u o; o.x = pk2(s[0 * 33], s[1 * 33]); o.y = pk2(s[2 * 33], s[3 * 33]); o.z = pk2(s[4 * 33], s[5 * 33]); o.w = pk2(s[6 * 33], s[7 * 33]);
        *(GAS v4u*)(WT + (size_t)(n0 + n) * K + k0 + 8 * c) = o; }
    LDS_WAIT(); asm volatile("" ::: "memory");
}

__device__ __forceinline__ void phase_p0(Frame& F) {
    const int gt = F.vcu * NT + F.tid, NGT = F.G * NT;
    bf16* CS = (bf16*)(F.ws + WS_CS);
    for (int i = gt; i < 144 * D; i += NGT) {
        const int r = i / D, c = i % D; float v = 0.f;
        if (r < NBP) v = F.ka->in[4][(size_t)r * D + c]; else if (r < NCOND) v = F.ka->in[5][(size_t)(r - NBP) * D + c];
        CS[i] = (bf16)f2bf(r < NCOND ? silu_f(v) : 0.f);
    }
    float* LB = (float*)(F.ws + WS_LB);
    for (int c = gt; c < D; c += NGT) {
        const float a0 = F.ka->in[11][c], a1 = F.ka->in[11][D + c], mx = fmaxf(a0, a1);
        const float e0 = expf(a0 - mx), e1 = expf(a1 - mx), s = e0 + e1, p0 = e0 / s, p1 = e1 / s;
        LB[c] = fminf(fmaxf(p0 - p0, 0.f), 1.0f - 1e-6f);
        LB[D + c] = fminf(fmaxf((p0 + p1) - p0, 0.f), 1.0f - 1e-6f);
    }
    for (int j = 0; j < 2; ++j) {
        bf16* WT = (bf16*)(F.ws + WS_GLWI) + (size_t)j * GL_INP * D + (size_t)6144 * D;
        const float* W = F.ka->in[14] + (size_t)j * D * GL_IN;
        for (int i = gt; i < 256 * D; i += NGT) { const int r = i / D, k = i % D; WT[i] = (bf16)(r < GL_R ? f2bf(W[(size_t)k * GL_IN + 6144 + r]) : 0u); }
    }
}

__device__ __forceinline__ void phase_p1(Frame& F) {
    {
        const bf16* CS = (const bf16*)(F.ws + WS_CS);
        float* MOD = (float*)(F.ws + WS_MOD);
        const int fr = F.lane & 15, fq = F.lane >> 4, nt = F.wave & 3, kh = F.wave >> 2;
        LAS float* red = (LAS float*)F.lds;
        for (int it = F.vcu; it < (DEPTH * 6 * D) / 64; it += F.G) {
            const int nn = it * 64, l = nn / (6 * D), c0 = nn % (6 * D) + 16 * nt;
            const float* W = F.ka->in[6] + (size_t)l * D * (6 * D) + c0 + fr;
            f32x4 acc[9];
#pragma unroll
            for (int rt = 0; rt < 9; ++rt) acc[rt] = (f32x4){0.f, 0.f, 0.f, 0.f};
            for (int ks = 0; ks < 32; ++ks) {
                const int k0 = kh * 1024 + ks * 32 + 8 * fq;
                float w[8];
#pragma unroll
                for (int j = 0; j < 8; ++j) w[j] = W[(size_t)(k0 + j) * (6 * D)];
                v4u bw; bw.x = pk2(w[0], w[1]); bw.y = pk2(w[2], w[3]); bw.z = pk2(w[4], w[5]); bw.w = pk2(w[6], w[7]);
                const bf16x8 bfrag = __builtin_bit_cast(bf16x8, bw);
#pragma unroll
                for (int rt = 0; rt < 9; ++rt) {
                    const bf16x8 afrag = *(const bf16x8*)(CS + (size_t)(16 * rt + fr) * D + k0);
                    acc[rt] = __builtin_amdgcn_mfma_f32_16x16x32_bf16(afrag, bfrag, acc[rt], 0, 0, 0);
                }
            }
            if (kh == 1) {
#pragma unroll
                for (int rt = 0; rt < 9; ++rt) *(LAS f32x4*)(red + ((nt * 9 + rt) * 64 + F.lane) * 4) = acc[rt];
            }
            __syncthreads();
            if (kh == 0) {
                const float bias = F.ka->in[7][(size_t)l * (6 * D) + c0 + fr];
#pragma unroll
                for (int rt = 0; rt < 9; ++rt) {
                    const f32x4 o = acc[rt] + *(LAS f32x4*)(red + ((nt * 9 + rt) * 64 + F.lane) * 4);
#pragma unroll
                    for (int j = 0; j < 4; ++j) { const int row = 16 * rt + 4 * fq + j; if (row < NCOND) MOD[((size_t)row * DEPTH + l) * (6 * D) + c0 + fr] = o[j] + bias; }
                }
            }
            __syncthreads();
        }
    }
    LAS float* scr = (LAS float*)(F.lds + F.wave * 16384);
    const int gw = F.vcu * NWAVES + F.wave, NGW = F.G * NWAVES;
    constexpr int I_HGI = 32 * 256, I_SQ = 32 * 64, I_GLI = 32 * 192, I_UP = 32 * 256, I_DN = 128 * 64;
    constexpr int NITEMS = 2 * (I_HGI + I_SQ + I_GLI + I_SQ) + 4 * (I_UP + I_DN);
    for (int it = gw; it < NITEMS; it += NGW) {
        int r = it;
        if (r < 2 * I_HGI) { const int j = r / I_HGI; p0_transpose_item(F.ka->in[10] + (size_t)j * D * 8192, D, 8192, 8192, (bf16*)(F.ws + WS_HGWI) + (size_t)j * 8192 * D, scr, r % I_HGI, F.lane); continue; } r -= 2 * I_HGI;
        if (r < 2 * I_SQ) { const int j = r / I_SQ; p0_transpose_item(F.ka->in[13] + (size_t)j * D * D, D, D, D, (bf16*)(F.ws + WS_HGWO) + (size_t)j * D * D, scr, r % I_SQ, F.lane); continue; } r -= 2 * I_SQ;
        if (r < 2 * I_GLI) { const int j = r / I_GLI; p0_transpose_item(F.ka->in[14] + (size_t)j * D * GL_IN, D, GL_IN, 6144, (bf16*)(F.ws + WS_GLWI) + (size_t)j * GL_INP * D, scr, r % I_GLI, F.lane); continue; } r -= 2 * I_GLI;
        if (r < 2 * I_SQ) { const int j = r / I_SQ; p0_transpose_item(F.ka->in[18] + (size_t)j * D * D, D, D, D, (bf16*)(F.ws + WS_GLWO) + (size_t)j * D * D, scr, r % I_SQ, F.lane); continue; } r -= 2 * I_SQ;
        if (r < 4 * I_UP) { const int l = r / I_UP; p0_transpose_item(F.ka->in[19] + (size_t)l * D * DFF, D, DFF, DFF, (bf16*)(F.ws + WS_WUP) + (size_t)l * DFF * D, scr, r % I_UP, F.lane); continue; } r -= 4 * I_UP;
        { const int l = r / I_DN; p0_transpose_item(F.ka->in[20] + (size_t)l * DFF * D, DFF, D, D, (bf16*)(F.ws + WS_WDN) + (size_t)l * D * DFF, scr, r % I_DN, F.lane); }
    }
}

__device__ __forceinline__ void row_load(const float* p, int lane, f32x4 (&v)[8]) {
    const GAS f32x4* xr = (const GAS f32x4*)p + lane;
#pragma unroll
    for (int j = 0; j < 8; ++j) v[j] = xr[64 * j];
}
__device__ __forceinline__ void row_modulate_store(const f32x4 (&x)[8], const float* sc, const float* sh, bf16* hrow, int lane) {
    GAS v2u* o8 = (GAS v2u*)hrow + lane;
#pragma unroll
    for (int j = 0; j < 8; ++j) {
        const f32x4 s = *((const GAS f32x4*)sc + lane + 64 * j), b = *((const GAS f32x4*)sh + lane + 64 * j);
        const f32x4 h = x[j] * (s + 1.0f) + b;
        v2u w; w.x = pk2(h[0], h[1]); w.y = pk2(h[2], h[3]); o8[64 * j] = w;
    }
}
__device__ __forceinline__ void phase_p2(Frame& F) {
    const int gw = F.vcu * NWAVES + F.wave, NGW = F.G * NWAVES;
    float* X = (float*)(F.ws + WS_X); bf16* H = (bf16*)(F.ws + WS_H); const float* MOD = (const float*)(F.ws + WS_MOD);
    for (int r = gw; r < M; r += NGW) {
        const float* src = r < MP ? F.ka->in[0] + (size_t)r * D : F.ka->in[1] + (size_t)(r - MP) * D;
        f32x4 v[8]; row_load(src, F.lane, v);
        GAS f32x4* xo = (GAS f32x4*)(X + (size_t)r * D) + F.lane;
#pragma unroll
        for (int j = 0; j < 8; ++j) xo[64 * j] = v[j];
        const float* md = MOD + (size_t)cond_of_row(r) * (DEPTH * 6 * D);
        row_modulate_store(v, md + D, md, H + (size_t)r * D, F.lane);
    }
}
__device__ __forceinline__ void phase_ln(Frame& F, const float* lnw, const float* lnb, int sc_off, int sh_off, bool last) {
    const int gw = F.vcu * NWAVES + F.wave, NGW = F.G * NWAVES;
    const float* Z = (const float*)(F.ws + WS_Z); float* X = (float*)(F.ws + WS_X); bf16* H = (bf16*)(F.ws + WS_H); const float* MOD = (const float*)(F.ws + WS_MOD);
    for (int r = gw; r < M; r += NGW) {
        f32x4 v[8]; row_load(Z + (size_t)r * D, F.lane, v);
        float s = 0.f;
#pragma unroll
        for (int j = 0; j < 8; ++j) s += (v[j][0] + v[j][1]) + (v[j][2] + v[j][3]);
        const float mean = wave_sum(s) * (1.0f / D); float s2 = 0.f;
#pragma unroll
        for (int j = 0; j < 8; ++j) { v[j] = v[j] - mean; s2 += (v[j][0] * v[j][0] + v[j][1] * v[j][1]) + (v[j][2] * v[j][2] + v[j][3] * v[j][3]); }
        const float rstd = 1.0f / sqrtf(wave_sum(s2) * (1.0f / D) + LN_EPS);
#pragma unroll
        for (int j = 0; j < 8; ++j) {
            const f32x4 w = *((const GAS f32x4*)lnw + F.lane + 64 * j), b = *((const GAS f32x4*)lnb + F.lane + 64 * j);
            v[j] = v[j] * rstd * w + b;
        }
        float* dst = last ? (r < MP ? F.out + O_YP + (size_t)r * D : F.out + O_YS + (size_t)(r - MP) * D) : X + (size_t)r * D;
        GAS f32x4* xo = (GAS f32x4*)dst + F.lane;
#pragma unroll
        for (int j = 0; j < 8; ++j) xo[64 * j] = v[j];
        if (!last) {
            const float* md = MOD + (size_t)cond_of_row(r) * (DEPTH * 6 * D);
            row_modulate_store(v, md + sc_off, md + sh_off, H + (size_t)r * D, F.lane);
        }
    }
}

template <bool GLA> struct RecCfg {
    static constexpr int K = GLA ? GL_K : HG_K, V = GLA ? GL_V : HG_V, H = GLA ? GL_H : HG_H;
    static constexpr int LDQK = GLA ? GL_KD : D;
    static constexpr int SSEG = NT / K, L = CH / SSEG;
    static constexpr int KP = K + 8;
    static constexpr int SP = CH + 8;
};
struct RecArgs {
    const bf16 *QB, *KB, *VB, *GB; const float* LF;
    bf16* O; bf16* ST;
    const float* normw;
    const float* wgk2; const float* bgk;
    const float* s_in; float* s_out_sample; float* s_out_prompt;
};
__device__ __forceinline__ float clamp_exp(float x) { return fast_exp(fminf(x, 80.f)); }

template <bool GLA> struct ColW { float w2[GLA ? 16 : 1]; float bg; };

template <bool GLA, int N> __device__ __forceinline__ void load_lf(const RecArgs& A, const ColW<GLA>& cw, const LAS float* gkl, int grow0, int lrow0, int colg, float (&lf)[N]) {
    if constexpr (GLA) {
#pragma unroll
        for (int i = 0; i < N; ++i) {
            const LAS f32x4* g = (const LAS f32x4*)(gkl + (lrow0 + i) * 16);
            float x = cw.bg;
#pragma unroll
            for (int q = 0; q < 4; ++q) { const f32x4 gv = g[q]; x += gv[0] * cw.w2[4 * q] + gv[1] * cw.w2[4 * q + 1] + gv[2] * cw.w2[4 * q + 2] + gv[3] * cw.w2[4 * q + 3]; }
            lf[i] = logsigmoid_f(x) * 0.0625f;
            if ((i & 1) == 1) asm volatile("" : "+v"(lf[i - 1]), "+v"(lf[i]) :: "memory");
        }
    } else {
#pragma unroll
        for (int i = 0; i < N; ++i) lf[i] = A.LF[(size_t)(grow0 + i) * D + colg];
    }
}

template <bool GLA> __device__ __forceinline__ void rec_pass_a(Frame& F, const RecArgs& A) {
    typedef RecCfg<GLA> C; constexpr int K = C::K, V = C::V, H = C::H, SSEG = C::SSEG, L = C::L, SP = C::SP, NVS = V / 32, KT = K / 16, TPW = KT * 2 / 8;
    LAS bf16* Kht = (LAS bf16*)F.lds;
    LAS bf16* Vt = Kht + K * SP;
    LAS float* segtot = (LAS float*)(Vt + 32 * SP);
    LAS float* eR = segtot + SSEG * K; LAS float* dU = eR + K; LAS float* dD = dU + K;
    LAS float* gkl = dD + K;
    LAS float* smp = gkl + 64 * 16;
    const int tid = F.tid, lane = F.lane, wave = F.wave, fr = lane & 15, fq = lane >> 4;
    const int k = tid % K, sg = tid / K;
    for (int it = F.vcu; it < NBP * H * NVS; it += F.G) {
        const int b = it / (H * NVS), h = (it / NVS) % H, vs = it % NVS;
        ColW<GLA> cw; cw.bg = 0.f;
        if constexpr (GLA) {
#pragma unroll
            for (int r = 0; r < 16; ++r) cw.w2[r] = A.wgk2[r * GL_KD + h * K + k];
            cw.bg = A.bgk[h * K + k];
        }
        f32x4 S[TPW];
#pragma unroll
        for (int i = 0; i < TPW; ++i) S[i] = (f32x4){0.f, 0.f, 0.f, 0.f};
        bf16* STi = A.ST + (size_t)((b * H + h) * NCH) * V * K;
        for (int c = 0; c < NCH; ++c) {
            const int R0 = b * SEQ + c * CH;
            if constexpr (GLA) {
                if (tid < 256) *(LAS f32x4*)(gkl + (tid >> 2) * 16 + (tid & 3) * 4) = *(const f32x4*)(A.LF + (size_t)(R0 + (tid >> 2)) * GL_R + (tid & 3) * 4);
                __syncthreads();
            }
            float lf[L], kv[L];
            load_lf<GLA, L>(A, cw, gkl, R0 + sg * L, sg * L, h * K + k, lf);
#pragma unroll
            for (int i = 0; i < L; ++i) kv[i] = bf2f(A.KB[(size_t)(R0 + sg * L + i) * C::LDQK + h * K + k]);
            v4u vraw = (v4u){0u, 0u, 0u, 0u};
            if (tid < 256) vraw = *(const v4u*)(A.VB + (size_t)(R0 + (tid & 63)) * D + h * V + vs * 32 + (tid >> 6) * 8);
#pragma unroll
            for (int i = 1; i < L; ++i) lf[i] += lf[i - 1];
            segtot[sg * K + k] = lf[L - 1];
            __syncthreads();
            float pre = 0.f, tot = 0.f, rr = 0.f;
#pragma unroll
            for (int s2 = 0; s2 < SSEG; ++s2) { const float t = segtot[s2 * K + k]; if (s2 < sg) pre += t; if (s2 < SSEG / 2) rr += t; tot += t; }
            {
                unsigned pk[L / 2];
#pragma unroll
                for (int i = 0; i < L; i += 2) pk[i / 2] = pk2(kv[i] * clamp_exp(rr - (pre + lf[i])), kv[i + 1] * clamp_exp(rr - (pre + lf[i + 1])));
#pragma unroll
                for (int i = 0; i < L / 8; ++i) *(LAS v4u*)(Kht + k * SP + sg * L + 8 * i) = (v4u){pk[4 * i], pk[4 * i + 1], pk[4 * i + 2], pk[4 * i + 3]};
            }
            if (sg == 0) { eR[k] = fast_exp(rr); dU[k] = fast_exp(tot - rr); dD[k] = fast_exp(tot); }
            if (tid < 256) {
                const int s = tid & 63, v0 = (tid >> 6) * 8;
                Vt[(v0 + 0) * SP + s] = (bf16)(vraw.x & 0xffffu); Vt[(v0 + 1) * SP + s] = (bf16)(vraw.x >> 16);
                Vt[(v0 + 2) * SP + s] = (bf16)(vraw.y & 0xffffu); Vt[(v0 + 3) * SP + s] = (bf16)(vraw.y >> 16);
                Vt[(v0 + 4) * SP + s] = (bf16)(vraw.z & 0xffffu); Vt[(v0 + 5) * SP + s] = (bf16)(vraw.z >> 16);
                Vt[(v0 + 6) * SP + s] = (bf16)(vraw.w & 0xffffu); Vt[(v0 + 7) * SP + s] = (bf16)(vraw.w >> 16);
            }
            __syncthreads();
#pragma unroll
            for (int i = 0; i < TPW; ++i) {
                const int tile = wave * TPW + i, kt = tile >> 1, vt = tile & 1;
                f32x4 u = (f32x4){0.f, 0.f, 0.f, 0.f};
#pragma unroll
                for (int ks = 0; ks < 2; ++ks) {
                    const bf16x8 a = *(const LAS bf16x8*)(Kht + (16 * kt + fr) * SP + 32 * ks + 8 * fq);
                    const bf16x8 bb = *(const LAS bf16x8*)(Vt + (16 * vt + fr) * SP + 32 * ks + 8 * fq);
                    u = __builtin_amdgcn_mfma_f32_16x16x32_bf16(a, bb, u, 0, 0, 0);
                }
                const int k4 = 16 * kt + 4 * fq;
                const f32x4 er = *(const LAS f32x4*)(eR + k4), du = *(const LAS f32x4*)(dU + k4), dd = *(const LAS f32x4*)(dD + k4);
                const f32x4 sp = S[i] * er;
                v2u w; w.x = pk2(sp[0], sp[1]); w.y = pk2(sp[2], sp[3]);
                *(v2u*)(STi + (size_t)c * V * K + (size_t)(vs * 32 + 16 * vt + fr) * K + k4) = w;
                S[i] = S[i] * dd + u * du;
            }
            __syncthreads();
        }
#pragma unroll
        for (int i = 0; i < TPW; ++i) {
            const int tile = wave * TPW + i, kt = tile >> 1, vt = tile & 1;
            float* o = A.s_out_prompt + ((size_t)(b * H + h) * K + 16 * kt + 4 * fq) * V + vs * 32 + 16 * vt + fr;
#pragma unroll
            for (int j = 0; j < 4; ++j) o[(size_t)j * V] = S[i][j];
        }
    }
    {
        constexpr int V4 = V / 4, NKG = NT / V4, RPG = K / NKG;
        LAS float* dvec = smp;
        LAS float* ktil = dvec + K;
        LAS float* qtil = ktil + 4 * K;
        LAS float* apart = qtil + 4 * K;
        LAS float* opart = apart + 64;
        LAS float* rpart = opart + NKG * 4 * V;
        for (int it = F.vcu; it < NBS * H; it += F.G) {
            const int b = it / H, h = it % H, R0 = MP + b * TS;
            if constexpr (GLA) {
                if (tid < 16) *(LAS f32x4*)(gkl + (tid >> 2) * 16 + (tid & 3) * 4) = *(const f32x4*)(A.LF + (size_t)(R0 + (tid >> 2)) * GL_R + (tid & 3) * 4);
                __syncthreads();
            }
            if (tid < K) {
                ColW<GLA> cw; cw.bg = 0.f;
                if constexpr (GLA) {
#pragma unroll
                    for (int r = 0; r < 16; ++r) cw.w2[r] = A.wgk2[r * GL_KD + h * K + tid];
                    cw.bg = A.bgk[h * K + tid];
                }
                float bt[4], q[4], kk[4];
                load_lf<GLA, 4>(A, cw, gkl, R0, 0, h * K + tid, bt);
#pragma unroll
                for (int t = 1; t < 4; ++t) bt[t] += bt[t - 1];
#pragma unroll
                for (int t = 0; t < 4; ++t) { q[t] = bf2f(A.QB[(size_t)(R0 + t) * C::LDQK + h * K + tid]); kk[t] = bf2f(A.KB[(size_t)(R0 + t) * C::LDQK + h * K + tid]); }
                dvec[tid] = fast_exp(bt[3]);
#pragma unroll
                for (int t = 0; t < 4; ++t) { ktil[t * K + tid] = kk[t] * fast_exp(bt[3] - bt[t]); qtil[t * K + tid] = q[t] * fast_exp(bt[t]); }
                float a[10];
#pragma unroll
                for (int t = 0; t < 4; ++t)
#pragma unroll
                    for (int s = 0; s <= t; ++s) a[t * (t + 1) / 2 + s] = q[t] * kk[s] * fast_exp(bt[t] - bt[s]);
#pragma unroll
                for (int i = 0; i < 10; ++i) { const float r = wave_sum(a[i]); if (lane == i) apart[wave * 16 + i] = r; }
            }
            __syncthreads();
            const int v4 = tid % V4, kg = tid / V4;
            f32x4 vs4[4];
#pragma unroll
            for (int s = 0; s < 4; ++s) { const v2u raw = *(const v2u*)(A.VB + (size_t)(R0 + s) * D + h * V + 4 * v4); vs4[s] = (f32x4){bflo(raw.x), bfhi(raw.x), bflo(raw.y), bfhi(raw.y)}; }
            f32x4 o[4];
#pragma unroll
            for (int t = 0; t < 4; ++t) o[t] = (f32x4){0.f, 0.f, 0.f, 0.f};
            const float* sin = A.s_in + (size_t)(b * H + h) * K * V + 4 * v4;
            float* sout = A.s_out_sample + (size_t)(b * H + h) * K * V + 4 * v4;
#pragma unroll 4
            for (int i = 0; i < RPG; ++i) {
                const int kr = kg * RPG + i;
                const f32x4 s4 = *(const f32x4*)(sin + (size_t)kr * V);
                f32x4 sn = s4 * dvec[kr];
#pragma unroll
                for (int t = 0; t < 4; ++t) { o[t] += s4 * qtil[t * K + kr]; sn += vs4[t] * ktil[t * K + kr]; }
                *(f32x4*)(sout + (size_t)kr * V) = sn;
            }
#pragma unroll
            for (int t = 0; t < 4; ++t) *(LAS f32x4*)(opart + (kg * 4 + t) * V + 4 * v4) = o[t];
            __syncthreads();
            const int t = tid / V4;
            f32x4 ov = (f32x4){0.f, 0.f, 0.f, 0.f};
            if (t < 4) {
#pragma unroll
                for (int g = 0; g < NKG; ++g) ov += *(const LAS f32x4*)(opart + (g * 4 + t) * V + 4 * v4);
#pragma unroll
                for (int s = 0; s < 4; ++s) if (s <= t) { float as = 0.f;
#pragma unroll
                    for (int w = 0; w < K / 64; ++w) as += apart[w * 16 + t * (t + 1) / 2 + s];
                    ov += vs4[s] * as; }
            }
            float ss = ov[0] * ov[0] + ov[1] * ov[1] + ov[2] * ov[2] + ov[3] * ov[3];
            float tot;
            if constexpr (GLA) {
                const float ws = wave_sum(ss);
                if (lane == 0) rpart[wave] = ws;
                __syncthreads();
                tot = rpart[(wave & ~1)] + rpart[(wave | 1)];
            } else {
#pragma unroll
                for (int ofs = 1; ofs < 32; ofs <<= 1) ss += __shfl_xor(ss, ofs);
                tot = ss;
            }
            if (t < 4) {
                const float rstd = 1.0f / sqrtf(tot * (1.0f / V) + LN_EPS);
                const f32x4 nw = *(const f32x4*)(A.normw + h * V + 4 * v4);
                const v2u graw = *(const v2u*)(A.GB + (size_t)(R0 + t) * D + h * V + 4 * v4);
                const f32x4 gt = (f32x4){bflo(graw.x), bfhi(graw.x), bflo(graw.y), bfhi(graw.y)};
                const f32x4 r = ov * rstd * nw * gt;
                v2u w; w.x = pk2(r[0], r[1]); w.y = pk2(r[2], r[3]);
                *(v2u*)(A.O + (size_t)(R0 + t) * D + h * V + 4 * v4) = w;
            }
            __syncthreads();
        }
    }
}

template <bool GLA> __device__ __forceinline__ void rec_pass_b(Frame& F, const RecArgs& A) {
    typedef RecCfg<GLA> C; constexpr int K = C::K, V = C::V, H = C::H, SSEG = C::SSEG, L = C::L, KP = C::KP, SP = C::SP, VTW = (V / 16) / 8, KS = K / 32;
    LAS bf16* Qh = (LAS bf16*)F.lds;
    LAS bf16* Kh = Qh + CH * KP;
    LAS bf16* P = Kh + CH * KP;
    LAS bf16* Vt = P + CH * SP;
    LAS float* segtot = (LAS float*)(Vt + V * SP);
    LAS float* gkl = segtot + SSEG * K;
    LAS float* part = gkl + 64 * 16;
    const int tid = F.tid, lane = F.lane, wave = F.wave, fr = lane & 15, fq = lane >> 4;
    const int k = tid % K, sg = tid / K;
    for (int it = F.vcu; it < NBP * NCH * H; it += F.G) {
        const int h = it % H, c = (it / H) % NCH, b = it / (H * NCH), R0 = b * SEQ + c * CH;
        ColW<GLA> cw; cw.bg = 0.f;
        if constexpr (GLA) {
#pragma unroll
            for (int r = 0; r < 16; ++r) cw.w2[r] = A.wgk2[r * GL_KD + h * K + k];
            cw.bg = A.bgk[h * K + k];
            if (tid < 256) *(LAS f32x4*)(gkl + (tid >> 2) * 16 + (tid & 3) * 4) = *(const f32x4*)(A.LF + (size_t)(R0 + (tid >> 2)) * GL_R + (tid & 3) * 4);
            __syncthreads();
        }
#pragma unroll
        for (int i = 0; i < V / 64; ++i) {
            const int s = tid & 63, v0 = (wave + 8 * i) * 8;
            const v4u raw = *(const v4u*)(A.VB + (size_t)(R0 + s) * D + h * V + v0);
            Vt[(v0 + 0) * SP + s] = (bf16)(raw.x & 0xffffu); Vt[(v0 + 1) * SP + s] = (bf16)(raw.x >> 16);
            Vt[(v0 + 2) * SP + s] = (bf16)(raw.y & 0xffffu); Vt[(v0 + 3) * SP + s] = (bf16)(raw.y >> 16);
            Vt[(v0 + 4) * SP + s] = (bf16)(raw.z & 0xffffu); Vt[(v0 + 5) * SP + s] = (bf16)(raw.z >> 16);
            Vt[(v0 + 6) * SP + s] = (bf16)(raw.w & 0xffffu); Vt[(v0 + 7) * SP + s] = (bf16)(raw.w >> 16);
        }
        {
            float lf[L];
            load_lf<GLA, L>(A, cw, gkl, R0 + sg * L, sg * L, h * K + k, lf);
#pragma unroll
            for (int i = 1; i < L; ++i) lf[i] += lf[i - 1];
            segtot[sg * K + k] = lf[L - 1];
            __syncthreads();
            float pre = 0.f, rr = 0.f;
#pragma unroll
            for (int s2 = 0; s2 < SSEG; ++s2) { const float t = segtot[s2 * K + k]; if (s2 < sg) pre += t; if (s2 < SSEG / 2) rr += t; }
#pragma unroll
            for (int i = 0; i < L; ++i) {
                const int s = sg * L + i;
                const float bb = pre + lf[i];
                const float qv = bf2f(A.QB[(size_t)(R0 + s) * C::LDQK + h * K + k]), kv = bf2f(A.KB[(size_t)(R0 + s) * C::LDQK + h * K + k]);
                Qh[s * KP + k] = (bf16)f2bf(qv * clamp_exp(bb - rr));
                Kh[s * KP + k] = (bf16)f2bf(kv * clamp_exp(rr - bb));
            }
        }
        __syncthreads();
#pragma unroll
        for (int i = 0; i < 2; ++i) {
            const int tile = wave * 2 + i, st = tile >> 2, tt = tile & 3;
            f32x4 a4 = (f32x4){0.f, 0.f, 0.f, 0.f};
            if (st <= tt) {
#pragma unroll
                for (int ks = 0; ks < KS; ++ks) {
                    const bf16x8 a = *(const LAS bf16x8*)(Kh + (16 * st + fr) * KP + 32 * ks + 8 * fq);
                    const bf16x8 bq = *(const LAS bf16x8*)(Qh + (16 * tt + fr) * KP + 32 * ks + 8 * fq);
                    a4 = __builtin_amdgcn_mfma_f32_16x16x32_bf16(a, bq, a4, 0, 0, 0);
                }
                const int t = 16 * tt + fr;
#pragma unroll
                for (int j = 0; j < 4; ++j) if (16 * st + 4 * fq + j > t) a4[j] = 0.f;
            }
            v2u w; w.x = pk2(a4[0], a4[1]); w.y = pk2(a4[2], a4[3]);
            *(LAS v2u*)(P + (16 * tt + fr) * SP + 16 * st + 4 * fq) = w;
        }
        __syncthreads();
        const bf16* STi = A.ST + (size_t)((b * H + h) * NCH + c) * V * K;
        f32x4 acc[VTW][4];
        float ssq[4] = {0.f, 0.f, 0.f, 0.f};
#pragma unroll
        for (int iv = 0; iv < VTW; ++iv) {
            const int vt = wave * VTW + iv;
#pragma unroll
            for (int tt = 0; tt < 4; ++tt) acc[iv][tt] = (f32x4){0.f, 0.f, 0.f, 0.f};
#pragma unroll
            for (int ks = 0; ks < 2; ++ks) {
                const bf16x8 a = *(const LAS bf16x8*)(Vt + (16 * vt + fr) * SP + 32 * ks + 8 * fq);
#pragma unroll
                for (int tt = 0; tt < 4; ++tt) {
                    const bf16x8 bp = *(const LAS bf16x8*)(P + (16 * tt + fr) * SP + 32 * ks + 8 * fq);
                    acc[iv][tt] = __builtin_amdgcn_mfma_f32_16x16x32_bf16(a, bp, acc[iv][tt], 0, 0, 0);
                }
            }
#pragma unroll
            for (int ks = 0; ks < KS; ++ks) {
                const bf16x8 a = *(const bf16x8*)(STi + (size_t)(16 * vt + fr) * K + 32 * ks + 8 * fq);
#pragma unroll
                for (int tt = 0; tt < 4; ++tt) {
                    const bf16x8 bq = *(const LAS bf16x8*)(Qh + (16 * tt + fr) * KP + 32 * ks + 8 * fq);
                    acc[iv][tt] = __builtin_amdgcn_mfma_f32_16x16x32_bf16(a, bq, acc[iv][tt], 0, 0, 0);
                }
            }
#pragma unroll
            for (int tt = 0; tt < 4; ++tt) { const f32x4 x = acc[iv][tt]; ssq[tt] += (x[0] * x[0] + x[1] * x[1]) + (x[2] * x[2] + x[3] * x[3]); }
            asm volatile("" ::: "memory");
        }
#pragma unroll
        for (int tt = 0; tt < 4; ++tt) { float s = ssq[tt]; s += __shfl_xor(s, 16); s += __shfl_xor(s, 32); if (fq == 0) part[wave * 64 + 16 * tt + fr] = s; }
        __syncthreads();
#pragma unroll
        for (int tt = 0; tt < 4; ++tt) {
            const int t = 16 * tt + fr; float tot = 0.f;
#pragma unroll
            for (int w = 0; w < 8; ++w) tot += part[w * 64 + t];
            const float rstd = 1.0f / sqrtf(tot * (1.0f / V) + LN_EPS);
#pragma unroll
            for (int iv = 0; iv < VTW; ++iv) {
                const int v0 = 16 * (wave * VTW + iv) + 4 * fq;
                const f32x4 nw = *(const f32x4*)(A.normw + h * V + v0);
                const v2u graw = *(const v2u*)(A.GB + (size_t)(R0 + t) * D + h * V + v0);
                const f32x4 gt = (f32x4){bflo(graw.x), bfhi(graw.x), bflo(graw.y), bfhi(graw.y)};
                const f32x4 r = acc[iv][tt] * rstd * nw * gt;
                v2u w; w.x = pk2(r[0], r[1]); w.y = pk2(r[2], r[3]);
                *(v2u*)(A.O + (size_t)(R0 + t) * D + h * V + v0) = w;
            }
        }
        __syncthreads();
    }
}

constexpr int NPHASE = 3 + 8 * DEPTH;
__device__ __forceinline__ RecArgs rec_args_hg(const Frame& F, int j) {
    RecArgs ra;
    ra.QB = (const bf16*)(F.ws + WS_QB); ra.KB = (const bf16*)(F.ws + WS_KB); ra.VB = (const bf16*)(F.ws + WS_VB); ra.GB = (const bf16*)(F.ws + WS_GB); ra.LF = (const float*)(F.ws + WS_LF);
    ra.O = (bf16*)(F.ws + WS_O); ra.ST = (bf16*)(F.ws + WS_ST);
    ra.normw = F.ka->in[12] + (size_t)j * D; ra.wgk2 = nullptr; ra.bgk = nullptr;
    ra.s_in = F.ka->in[2] + (size_t)j * NBS * HG_H * HG_K * HG_V; ra.s_out_sample = F.out + O_HGS + (size_t)j * NBS * HG_H * HG_K * HG_V; ra.s_out_prompt = F.out + O_HGP + (size_t)j * NBP * HG_H * HG_K * HG_V;
    return ra;
}
__device__ __forceinline__ RecArgs rec_args_gla(const Frame& F, int j) {
    RecArgs ra;
    ra.QB = (const bf16*)(F.ws + WS_QB); ra.KB = (const bf16*)(F.ws + WS_KB); ra.VB = (const bf16*)(F.ws + WS_VB); ra.GB = (const bf16*)(F.ws + WS_GB); ra.LF = (const float*)(F.ws + WS_LF);
    ra.O = (bf16*)(F.ws + WS_O); ra.ST = (bf16*)(F.ws + WS_ST);
    ra.normw = F.ka->in[17] + (size_t)j * D; ra.wgk2 = F.ka->in[15] + (size_t)j * GL_R * GL_KD; ra.bgk = F.ka->in[16] + (size_t)j * GL_KD;
    ra.s_in = F.ka->in[3] + (size_t)j * NBS * GL_H * GL_K * GL_V; ra.s_out_sample = F.out + O_GLS + (size_t)j * NBS * GL_H * GL_K * GL_V; ra.s_out_prompt = F.out + O_GLP + (size_t)j * NBP * GL_H * GL_K * GL_V;
    return ra;
}
__global__ void __launch_bounds__(NT, 2) fwd_kernel(Args args) {
    const int lo = args.ph_lo, hi = args.ph_hi;
    {
        Frame F = mk_frame();
        if (F.tid < 32) F.MISC[F.tid] = 0u;
        __syncthreads();
        if (!MK_PER_PHASE) (void)xcd_barrier_post((unsigned*)F.ws + CW_BAR, F.MISC);
    }
#define IN(k) (lo <= (k) && (k) < hi)
#define SEAM(k) do { if (IN(k) && IN((k) + 1)) { Frame Fb = mk_frame(); XcdBarrier bar; bar.bar = (unsigned*)Fb.ws + CW_BAR; bar.x = xb_xcc_id(); bar.st = Fb.MISC; xcd_barrier(bar); } } while (0)

    if (IN(0)) { Frame F = mk_frame(); phase_p0(F); } SEAM(0);
    if (IN(1)) { Frame F = mk_frame(); phase_p1(F); } SEAM(1);
    if (IN(2)) { Frame F = mk_frame(); phase_p2(F); } SEAM(2);

#pragma nounroll
    for (int l = 0; l < DEPTH; ++l) {
        const int p0 = 3 + 8 * l, j = l >> 1;
        if ((l & 1) == 0) {
            if (IN(p0)) {
                Frame F = mk_frame();
                pg8::Gemm g{(const bf16*)(F.ws + WS_H), (const bf16*)(F.ws + WS_HGWI) + (size_t)j * 8192 * D, M, 8192, D}; pg8::StaticOrder S; S.init(M, 8192, F.G, F.bx);
                EpiHgIn E{(bf16*)(F.ws + WS_QB), (bf16*)(F.ws + WS_KB), (bf16*)(F.ws + WS_VB), (bf16*)(F.ws + WS_GB), (float*)(F.ws + WS_LF), (const float*)(F.ws + WS_LB) + j * D};
                pg8::gemm_phase<EpiHgIn, pg8::StaticOrder, true, true>(F.lds, g, S, E);
            }
            SEAM(p0);
            if (IN(p0 + 1)) { Frame F = mk_frame(); const RecArgs ra = rec_args_hg(F, j); rec_pass_a<false>(F, ra); }
            SEAM(p0 + 1);
            if (IN(p0 + 2)) { Frame F = mk_frame(); const RecArgs ra = rec_args_hg(F, j); rec_pass_b<false>(F, ra); }
            SEAM(p0 + 2);
            if (IN(p0 + 3)) {
                Frame F = mk_frame();
                pg8::Gemm g{(const bf16*)(F.ws + WS_O), (const bf16*)(F.ws + WS_HGWO) + (size_t)j * D * D, M, D, D}; pg8::StaticOrder S; S.init(M, D, F.G, F.bx);
                EpiRes E{(const float*)(F.ws + WS_X), (float*)(F.ws + WS_Z), (const float*)(F.ws + WS_MOD) + (size_t)(l * 6 + 2) * D};
                pg8::gemm_phase<EpiRes, pg8::StaticOrder, true, true>(F.lds, g, S, E);
            }
            SEAM(p0 + 3);
        } else {
            if (IN(p0)) {
                Frame F = mk_frame();
                pg8::Gemm g{(const bf16*)(F.ws + WS_H), (const bf16*)(F.ws + WS_GLWI) + (size_t)j * GL_INP * D, M, GL_INP, D}; pg8::StaticOrder S; S.init(M, GL_INP, F.G, F.bx);
                EpiGlaIn E{(bf16*)(F.ws + WS_QB), (bf16*)(F.ws + WS_KB), (bf16*)(F.ws + WS_VB), (bf16*)(F.ws + WS_GB), (float*)(F.ws + WS_LF)};
                pg8::gemm_phase<EpiGlaIn, pg8::StaticOrder, true, true>(F.lds, g, S, E);
            }
            SEAM(p0);
            if (IN(p0 + 1)) { Frame F = mk_frame(); const RecArgs ra = rec_args_gla(F, j); rec_pass_a<true>(F, ra); }
            SEAM(p0 + 1);
            if (IN(p0 + 2)) { Frame F = mk_frame(); const RecArgs ra = rec_args_gla(F, j); rec_pass_b<true>(F, ra); }
            SEAM(p0 + 2);
            if (IN(p0 + 3)) {
                Frame F = mk_frame();
                pg8::Gemm g{(const bf16*)(F.ws + WS_O), (const bf16*)(F.ws + WS_GLWO) + (size_t)j * D * D, M, D, D}; pg8::StaticOrder S; S.init(M, D, F.G, F.bx);
                EpiRes E{(const float*)(F.ws + WS_X), (float*)(F.ws + WS_Z), (const float*)(F.ws + WS_MOD) + (size_t)(l * 6 + 2) * D};
                pg8::gemm_phase<EpiRes, pg8::StaticOrder, true, true>(F.lds, g, S, E);
            }
            SEAM(p0 + 3);
        }
        if (IN(p0 + 4)) { Frame F = mk_frame(); phase_ln(F, F.ka->in[8] + (size_t)(l * 2 + 0) * D, F.ka->in[9] + (size_t)(l * 2 + 0) * D, (l * 6 + 4) * D, (l * 6 + 3) * D, false); }
        SEAM(p0 + 4);
        if (IN(p0 + 5)) {
            Frame F = mk_frame();
            pg8::Gemm g{(const bf16*)(F.ws + WS_H), (const bf16*)(F.ws + WS_WUP) + (size_t)l * DFF * D, M, DFF, D}; pg8::StaticOrder S; S.init(M, DFF, F.G, F.bx);
            EpiUp E{(bf16*)(F.ws + WS_U)};
            pg8::gemm_phase<EpiUp, pg8::StaticOrder, true, true>(F.lds, g, S, E);
        }
        SEAM(p0 + 5);
        if (IN(p0 + 6)) {
            Frame F = mk_frame();
            pg8::Gemm g{(const bf16*)(F.ws + WS_U), (const bf16*)(F.ws + WS_WDN) + (size_t)l * D * DFF, M, D, DFF}; pg8::StaticOrder S; S.init(M, D, F.G, F.bx);
            EpiRes E{(const float*)(F.ws + WS_X), (float*)(F.ws + WS_Z), (const float*)(F.ws + WS_MOD) + (size_t)(l * 6 + 5) * D};
            pg8::gemm_phase<EpiRes, pg8::StaticOrder, true, true>(F.lds, g, S, E);
        }
        SEAM(p0 + 6);
        if (IN(p0 + 7)) { Frame F = mk_frame(); phase_ln(F, F.ka->in[8] + (size_t)(l * 2 + 1) * D, F.ka->in[9] + (size_t)(l * 2 + 1) * D, ((l + 1) * 6 + 1) * D, ((l + 1) * 6 + 0) * D, l == DEPTH - 1); }
        if (l + 1 < DEPTH) SEAM(p0 + 7);
    }
#undef IN
#undef SEAM
}

extern "C" void kernel_launch(void* const* d_in, const int* in_sizes, int n_in, void* d_out, int out_size, void* d_ws, size_t ws_size, hipStream_t stream) {
    static int grid = 0;
    if (grid == 0) {
        if (n_in != 21 || (size_t)out_size != O_END || ws_size < WS_END) { fprintf(stderr, "kernel_launch: unexpected problem (n_in %d, out %d, ws %zu; need out %zu, ws >= %zu); nothing launched\n", n_in, out_size, ws_size, (size_t)O_END, (size_t)WS_END); grid = -1; return; }
        int dev = 0, cus = 0, per_cu = 0;
        if (hipGetDevice(&dev) != hipSuccess || hipDeviceGetAttribute(&cus, hipDeviceAttributeMultiprocessorCount, dev) != hipSuccess) { grid = -1; return; }
        if (hipFuncSetAttribute((const void*)fwd_kernel, hipFuncAttributeMaxDynamicSharedMemorySize, LDS_BYTES) != hipSuccess) { fprintf(stderr, "kernel_launch: hipFuncSetAttribute failed\n"); grid = -1; return; }
        if (hipOccupancyMaxActiveBlocksPerMultiprocessor(&per_cu, (const void*)fwd_kernel, NT, LDS_BYTES) != hipSuccess || per_cu < 1) fprintf(stderr, "kernel_launch: occupancy query says %d\n", per_cu);
        (void)hipGetLastError();
        grid = cus;
    }
    if (grid < 0) return;
    if (hipMemsetAsync((char*)d_ws + WS_CTL, 0, CTL_ZERO_BYTES, stream) != hipSuccess) return;
    Args a{};
    for (int i = 0; i < 21; ++i) a.in[i] = (const float*)d_in[i];
    a.out = (float*)d_out; a.ws = (unsigned char*)d_ws;
#if MK_PER_PHASE
    for (int p = 0; p < NPHASE; ++p) { a.ph_lo = p; a.ph_hi = p + 1; hipLaunchKernelGGL(fwd_kernel, dim3(grid), dim3(NT), LDS_BYTES, stream, a); }
#else
    a.ph_lo = 0; a.ph_hi = NPHASE;
    hipLaunchKernelGGL(fwd_kernel, dim3(grid), dim3(NT), LDS_BYTES, stream, a);
#endif
    const hipError_t le = hipPeekAtLastError();
    if (le != hipSuccess) fprintf(stderr, "kernel_launch: launch failed: %s\n", hipGetErrorName(le));
}
```

```cpp
#define EXP_SERIAL 1
#include <hip/hip_runtime.h>
#include <cstdio>
#include <cstdint>
namespace pg8 {
#define PG8_LAS __attribute__((address_space(3)))
typedef unsigned short bf16_t;
typedef short bf16x8 __attribute__((ext_vector_type(8)));
typedef float f32x4 __attribute__((ext_vector_type(4)));
typedef unsigned u32x4 __attribute__((ext_vector_type(4)));
constexpr int BM = 256, BK = 64, HALF = 128, HTB = HALF * BK * 2  , STAGE_BYTES = 8 * HTB, NXCD = 8, WGM = 8;

__host__ __device__ __forceinline__ int lds_byte(int r, int c) { const int st = (r >> 4) * 2 + (c >> 5), rr = r & 15, cc = c & 31, ob = rr * 64 + cc * 2; return st * 1024 + (ob ^ (((ob >> 9) & 1) << 5)); }
__host__ __device__ __forceinline__ void stage_rc(int b, int& R, int& C) { const int st = b / 1024, sb = b % 1024, swz = sb ^ (((sb >> 9) & 1) << 5); R = (st >> 1) * 16 + swz / 64; C = (st & 1) * 32 + (swz % 64) / 2; }
__host__ __device__ __forceinline__ int perm32(int rho) { const int n = rho >> 4, i = rho & 15; return 8 * (i >> 2) + 4 * n + (i & 3); }

struct Unit { int pm, pn; };
struct Gemm { const bf16_t* A; const bf16_t* Bt; int M, N, K; };

struct StaticOrder {
    int nM, nN, nwg, G, c;
    __host__ __device__ void init(int M, int N, int G_, int c_) { nM = M / BM; nN = N / BM; nwg = nM * nN; G = G_; c = c_; }
    __host__ __device__ bool next(int i, Unit& u) const {
        const long L = (long)i * G + c; if (L >= nwg) return false;
        int wgid = (int)L; { const int q = nwg / NXCD, r = nwg % NXCD, xcd = wgid % NXCD, off = wgid / NXCD; wgid = (xcd < r ? xcd * (q + 1) : r * (q + 1) + (xcd - r) * q) + off; }
        const int nig = WGM * nN, gid = wgid / nig, fm = gid * WGM, gsz = (nM - fm) < WGM ? (nM - fm) : WGM;
        u.pm = fm + ((wgid % nig) % gsz); u.pn = (wgid % nig) / gsz; return true;
    }
    __device__ __forceinline__ void a_ready(const Unit&) const {}
    __device__ __forceinline__ void done(const Unit&) const {}
};

__device__ __forceinline__ unsigned cvt_pk_bf16(float lo, float hi) { unsigned r; asm volatile("v_cvt_pk_bf16_f32 %0, %1, %2" : "=v"(r) : "v"(lo), "v"(hi)); return r; }
template <class Epi, class Sched, bool ALIGN_EPI = false, bool SP2 = false>
__device__ __forceinline__ void gemm_phase(PG8_LAS unsigned char* lds, const Gemm g, const Sched& S, const Epi& E) {
    int tid_ = threadIdx.x; asm volatile("" : "+v"(tid_));
    const int tid = tid_, wid = __builtin_amdgcn_readfirstlane(tid >> 6), lane = tid & 63, wr = wid >> 2, wc = wid & 3, fr = lane & 15, fq = lane >> 4;
    const int K = g.K, nt = K / BK;
    unsigned voffA[2], voffB[2];
#pragma unroll
    for (int i = 0; i < 2; ++i) { int R, C; stage_rc(tid * 16 + i * 8192, R, C); const int Rb = Epi::PERM ? ((R & ~31) + perm32(R & 31)) : R;
        voffA[i] = (unsigned)(R * K + C) * 2u; voffB[i] = (unsigned)(Rb * K + C) * 2u; }
    const size_t kstep = (size_t)(BK * 2);
    const size_t hstep = (size_t)HALF * K * 2;
    const size_t tstep = 2 * hstep;
    const unsigned ldsw = (unsigned)wid * 1024u;
    const int aoff = lds_byte(wr * 64 + fr, fq * 8), boff = lds_byte(wc * 32 + fr, fq * 8);
#define PG8_SA(b, h) (((b) * 2 + (h)) * HTB)
#define PG8_SB(b, h) ((4 + (b) * 2 + (h)) * HTB)
#define PG8_STAGE(bufoff, gbase, voff) do { _Pragma("unroll") for (int _i = 0; _i < 2; ++_i) \
        __builtin_amdgcn_global_load_lds((const unsigned*)((const char*)(gbase) + (voff)[_i]), (PG8_LAS unsigned*)(lds + (bufoff) + ldsw + _i * 8192), 16, 0, 0); } while (0)
#define PG8_LDA(dst, b, h) do { _Pragma("unroll") for (int m = 0; m < 4; ++m) _Pragma("unroll") for (int k = 0; k < 2; ++k) dst[m][k] = *(const PG8_LAS bf16x8*)(lds + PG8_SA(b, h) + aoff + m * 2048 + k * 1024); } while (0)
#define PG8_LDB(dst, b, h) do { _Pragma("unroll") for (int n = 0; n < 2; ++n) _Pragma("unroll") for (int k = 0; k < 2; ++k) dst[n][k] = *(const PG8_LAS bf16x8*)(lds + PG8_SB(b, h) + boff + n * 2048 + k * 1024); } while (0)
#define PG8_MMA(ai, bj, At, Bt) do { __builtin_amdgcn_s_setprio(1); _Pragma("unroll") for (int m = 0; m < 4; ++m) _Pragma("unroll") for (int n = 0; n < 2; ++n) _Pragma("unroll") for (int k = 0; k < 2; ++k) \
        acc[ai][bj][m][n] = __builtin_amdgcn_mfma_f32_16x16x32_bf16(Bt[n][k], At[m][k], acc[ai][bj][m][n], 0, 0, 0); __builtin_amdgcn_s_setprio(0); } while (0)
#define PG8_WAIT_V(n) asm volatile("s_waitcnt vmcnt(" #n ")" ::: "memory")
#define PG8_WAIT_L(n) asm volatile("s_waitcnt lgkmcnt(" #n ")" ::: "memory")
#define PG8_BAR __builtin_amdgcn_s_barrier()
#define PG8_SCHED __builtin_amdgcn_sched_barrier(0)
    Unit cur, nxt; int ui = 0;
    if (!S.next(0, cur)) return;
    f32x4 acc[2][2][4][2];
#pragma unroll
    for (int a = 0; a < 2; ++a)
#pragma unroll
        for (int b = 0; b < 2; ++b)
#pragma unroll
            for (int m = 0; m < 4; ++m)
#pragma unroll
                for (int n = 0; n < 2; ++n) acc[a][b][m][n] = (f32x4){0.f, 0.f, 0.f, 0.f};
    bf16x8 At[4][2], B0[2][2], B1[2][2];
    const char* cA = (const char*)g.A + (size_t)cur.pm * tstep; const char* cB = (const char*)g.Bt + (size_t)cur.pn * tstep;
    S.a_ready(cur);
    if constexpr (SP2) {
        PG8_STAGE(PG8_SB(0, 0), cB, voffB); PG8_STAGE(PG8_SB(0, 1), cB + hstep, voffB); PG8_STAGE(PG8_SA(0, 0), cA, voffA); PG8_STAGE(PG8_SA(0, 1), cA + hstep, voffA);
        if (wr == 1) PG8_BAR;
        PG8_WAIT_V(2); PG8_BAR;
        PG8_STAGE(PG8_SB(1, 0), cB + kstep, voffB); PG8_STAGE(PG8_SA(1, 0), cA + kstep, voffA); PG8_STAGE(PG8_SB(1, 1), cB + hstep + kstep, voffB);
        PG8_WAIT_V(6); PG8_BAR;
    } else {
        PG8_STAGE(PG8_SB(0, 0), cB, voffB); PG8_STAGE(PG8_SA(0, 0), cA, voffA); PG8_STAGE(PG8_SB(0, 1), cB + hstep, voffB); PG8_STAGE(PG8_SA(0, 1), cA + hstep, voffA);
        if (wr == 1) PG8_BAR;
        PG8_WAIT_V(4); PG8_BAR;
        PG8_STAGE(PG8_SB(1, 0), cB + kstep, voffB); PG8_STAGE(PG8_SA(1, 0), cA + kstep, voffA); PG8_STAGE(PG8_SB(1, 1), cB + hstep + kstep, voffB);
        PG8_WAIT_V(6); PG8_BAR;
    }
    for (;;) {
        const bool has_next = S.next(ui + 1, nxt);
        const char* nA = has_next ? (const char*)g.A + (size_t)nxt.pm * tstep : cA; const char* nB = has_next ? (const char*)g.Bt + (size_t)nxt.pn * tstep : cB;
        for (int t = 0; t < nt; t += 2) {
            const bool last = (t == nt - 2);
            const char* a1 = cA + (size_t)(t + 1) * kstep;
            const char* a2 = last ? nA : cA + (size_t)(t + 2) * kstep; const char* b2 = last ? nB : cB + (size_t)(t + 2) * kstep;
            const char* a3 = a2 + kstep; const char* b3 = b2 + kstep;
            if (last && has_next) S.a_ready(nxt);
            if constexpr (SP2) {
            PG8_LDB(B0, 0, 0); PG8_LDB(B1, 0, 1); PG8_SCHED; PG8_LDA(At, 0, 0); PG8_STAGE(PG8_SA(1, 1), a1 + hstep, voffA);
            PG8_WAIT_V(8); PG8_WAIT_L(0); PG8_BAR; PG8_MMA(0, 0, At, B0); PG8_MMA(0, 1, At, B1); PG8_BAR; PG8_SCHED;
            PG8_LDA(At, 0, 1); PG8_STAGE(PG8_SB(0, 0), b2, voffB); PG8_STAGE(PG8_SB(0, 1), b2 + hstep, voffB); PG8_STAGE(PG8_SA(0, 0), a2, voffA);
            PG8_WAIT_V(8); PG8_WAIT_L(0); PG8_BAR; PG8_MMA(1, 0, At, B0); PG8_MMA(1, 1, At, B1); PG8_BAR; PG8_SCHED;
            PG8_LDB(B0, 1, 0); PG8_LDB(B1, 1, 1); PG8_SCHED; PG8_LDA(At, 1, 0); PG8_STAGE(PG8_SA(0, 1), a2 + hstep, voffA);
            PG8_WAIT_V(8); PG8_WAIT_L(0); PG8_BAR; PG8_MMA(0, 0, At, B0); PG8_MMA(0, 1, At, B1); PG8_BAR; PG8_SCHED;
            PG8_LDA(At, 1, 1); PG8_STAGE(PG8_SB(1, 0), b3, voffB); PG8_STAGE(PG8_SB(1, 1), b3 + hstep, voffB); PG8_STAGE(PG8_SA(1, 0), a3, voffA);
            PG8_WAIT_V(8); PG8_WAIT_L(0); PG8_BAR; PG8_MMA(1, 0, At, B0); PG8_MMA(1, 1, At, B1); PG8_BAR; PG8_SCHED;
            } else {
            PG8_LDB(B0, 0, 0); PG8_SCHED; PG8_LDA(At, 0, 0); PG8_STAGE(PG8_SA(1, 1), a1 + hstep, voffA);
            PG8_WAIT_L(8); PG8_BAR; PG8_WAIT_L(0); PG8_MMA(0, 0, At, B0); PG8_BAR; PG8_SCHED;
            PG8_LDB(B1, 0, 1); PG8_STAGE(PG8_SB(0, 0), b2, voffB);
            PG8_BAR; PG8_WAIT_L(0); PG8_MMA(0, 1, At, B1); PG8_BAR;
            PG8_LDA(At, 0, 1); PG8_STAGE(PG8_SA(0, 0), a2, voffA);
            PG8_BAR; PG8_WAIT_L(0); PG8_MMA(1, 0, At, B0); PG8_BAR; PG8_SCHED;
            PG8_STAGE(PG8_SB(0, 1), b2 + hstep, voffB);
            PG8_WAIT_V(6); PG8_BAR; PG8_MMA(1, 1, At, B1); PG8_BAR;
            PG8_LDB(B0, 1, 0); PG8_SCHED; PG8_LDA(At, 1, 0); PG8_STAGE(PG8_SA(0, 1), a2 + hstep, voffA);
            PG8_WAIT_L(8); PG8_BAR; PG8_WAIT_L(0); PG8_MMA(0, 0, At, B0); PG8_BAR; PG8_SCHED;
            PG8_LDB(B1, 1, 1); PG8_STAGE(PG8_SB(1, 0), b3, voffB);
            PG8_BAR; PG8_WAIT_L(0); PG8_MMA(0, 1, At, B1); PG8_BAR;
            PG8_LDA(At, 1, 1); PG8_STAGE(PG8_SA(1, 0), a3, voffA);
            PG8_BAR; PG8_WAIT_L(0); PG8_MMA(1, 0, At, B0); PG8_BAR; PG8_SCHED;
            PG8_STAGE(PG8_SB(1, 1), b3 + hstep, voffB);
            PG8_WAIT_V(6); PG8_BAR; PG8_MMA(1, 1, At, B1); PG8_BAR;
            }
        }
        if constexpr (ALIGN_EPI) { if (wr == 0) PG8_BAR; }
        if constexpr (!Epi::AFTER_DRAIN) { E(acc, cur, wr, wc, fr, fq); S.done(cur); }
        if (!has_next) break;
#pragma unroll
        for (int a = 0; a < 2; ++a)
#pragma unroll
            for (int b = 0; b < 2; ++b)
#pragma unroll
                for (int m = 0; m < 4; ++m)
#pragma unroll
                    for (int n = 0; n < 2; ++n) acc[a][b][m][n] = (f32x4){0.f, 0.f, 0.f, 0.f};
        cur = nxt; cA = nA; cB = nB; ++ui;
        if constexpr (ALIGN_EPI) { if (wr == 1) PG8_BAR; }
    }
    PG8_WAIT_V(0);
    if constexpr (!ALIGN_EPI) { if (wr == 0) PG8_BAR; }
    PG8_BAR;
    if constexpr (Epi::AFTER_DRAIN) { E.fused(acc, cur, wr, wc, fr, fq, lds, wid, lane); S.done(cur); }
#undef PG8_SA
#undef PG8_SB
#undef PG8_STAGE
#undef PG8_LDA
#undef PG8_LDB
#undef PG8_MMA
#undef PG8_WAIT_V
#undef PG8_WAIT_L
#undef PG8_BAR
#undef PG8_SCHED
}

struct GemmX { const bf16_t* A; const bf16_t* AX; const bf16_t* Bt; int N, K; };
constexpr int XS_OFF = STAGE_BYTES, XS_BYTES = 2048, STAGE_BYTES_X = STAGE_BYTES + 2 * XS_BYTES;
template <class Epi, class Sched>
__device__ __forceinline__ void gemm_phase_x(PG8_LAS unsigned char* lds, const GemmX g, const Sched& S, const Epi& E) {
    int tid_ = threadIdx.x; asm volatile("" : "+v"(tid_));
    const int tid = tid_, wid = __builtin_amdgcn_readfirstlane(tid >> 6), lane = tid & 63, wr = wid >> 2, wc = wid & 3, fr = lane & 15, fq = lane >> 4;
    const int K = g.K, nt = K / BK;
    unsigned voffA[2], voffB[2], voffX;
#pragma unroll
    for (int i = 0; i < 2; ++i) { int R, C; stage_rc(tid * 16 + i * 8192, R, C); const int Rb = Epi::PERM ? ((R & ~31) + perm32(R & 31)) : R;
        voffA[i] = (unsigned)(R * K + C) * 2u; voffB[i] = (unsigned)(Rb * K + C) * 2u; }
    { int R, C; stage_rc(tid * 4, R, C); voffX = (unsigned)(R * K + C) * 2u; }
    const size_t kstep = (size_t)(BK * 2);
    const size_t hstep = (size_t)HALF * K * 2;
    const size_t tstep = 2 * hstep;
    const size_t xstep = (size_t)16 * K * 2;
    const unsigned ldsw = (unsigned)wid * 1024u, ldsx = (unsigned)wid * 256u;
    const int aoff = lds_byte(wr * 64 + fr, fq * 8), boff = lds_byte(wc * 32 + fr, fq * 8), xoff = lds_byte(fr, fq * 8);
#define PG8_SA(b, h) (((b) * 2 + (h)) * HTB)
#define PG8_SB(b, h) ((4 + (b) * 2 + (h)) * HTB)
#define PG8_SX(b) (XS_OFF + (b) * XS_BYTES)
#define PG8_STAGE(bufoff, gbase, voff) do { _Pragma("unroll") for (int _i = 0; _i < 2; ++_i) \
        __builtin_amdgcn_global_load_lds((const unsigned*)((const char*)(gbase) + (voff)[_i]), (PG8_LAS unsigned*)(lds + (bufoff) + ldsw + _i * 8192), 16, 0, 0); } while (0)
#define PG8_STAGEX(b, gbase) __builtin_amdgcn_global_load_lds((const unsigned*)((const char*)(gbase) + voffX), (PG8_LAS unsigned*)(lds + PG8_SX(b) + ldsx), 4, 0, 0)
#define PG8_LDA(dst, b, h) do { _Pragma("unroll") for (int m = 0; m < 4; ++m) _Pragma("unroll") for (int k = 0; k < 2; ++k) dst[m][k] = *(const PG8_LAS bf16x8*)(lds + PG8_SA(b, h) + aoff + m * 2048 + k * 1024); } while (0)
#define PG8_LDB(dst, b, h) do { _Pragma("unroll") for (int n = 0; n < 2; ++n) _Pragma("unroll") for (int k = 0; k < 2; ++k) dst[n][k] = *(const PG8_LAS bf16x8*)(lds + PG8_SB(b, h) + boff + n * 2048 + k * 1024); } while (0)
#define PG8_LDX(b) do { _Pragma("unroll") for (int k = 0; k < 2; ++k) Ax[k] = *(const PG8_LAS bf16x8*)(lds + PG8_SX(b) + xoff + k * 1024); } while (0)
#define PG8_MMA(ai, bj, At, Bt) do { __builtin_amdgcn_s_setprio(1); _Pragma("unroll") for (int m = 0; m < 4; ++m) _Pragma("unroll") for (int n = 0; n < 2; ++n) _Pragma("unroll") for (int k = 0; k < 2; ++k) \
        acc[ai][bj][m][n] = __builtin_amdgcn_mfma_f32_16x16x32_bf16(Bt[n][k], At[m][k], acc[ai][bj][m][n], 0, 0, 0); __builtin_amdgcn_s_setprio(0); } while (0)
#define PG8_MMAX() do { __builtin_amdgcn_s_setprio(1); if (wr == 0) { _Pragma("unroll") for (int n = 0; n < 2; ++n) _Pragma("unroll") for (int k = 0; k < 2; ++k) accx[n] = __builtin_amdgcn_mfma_f32_16x16x32_bf16(B0[n][k], Ax[k], accx[n], 0, 0, 0); } \
        else { _Pragma("unroll") for (int n = 0; n < 2; ++n) _Pragma("unroll") for (int k = 0; k < 2; ++k) accx[n] = __builtin_amdgcn_mfma_f32_16x16x32_bf16(B1[n][k], Ax[k], accx[n], 0, 0, 0); } __builtin_amdgcn_s_setprio(0); } while (0)
#define PG8_WAIT_V(n) asm volatile("s_waitcnt vmcnt(" #n ")" ::: "memory")
#define PG8_WAIT_L(n) asm volatile("s_waitcnt lgkmcnt(" #n ")" ::: "memory")
#define PG8_BAR __builtin_amdgcn_s_barrier()
#define PG8_SCHED __builtin_amdgcn_sched_barrier(0)
    Unit cur, nxt; int ui = 0;
    if (!S.next(0, cur)) return;
    f32x4 acc[2][2][4][2], accx[2];
#pragma unroll
    for (int a = 0; a < 2; ++a)
#pragma unroll
        for (int b = 0; b < 2; ++b)
#pragma unroll
            for (int m = 0; m < 4; ++m)
#pragma unroll
                for (int n = 0; n < 2; ++n) acc[a][b][m][n] = (f32x4){0.f, 0.f, 0.f, 0.f};
    accx[0] = (f32x4){0.f, 0.f, 0.f, 0.f}; accx[1] = (f32x4){0.f, 0.f, 0.f, 0.f};
    bf16x8 At[4][2], B0[2][2], B1[2][2], Ax[2];
    const char* cA = (const char*)g.A + (size_t)cur.pm * tstep; const char* cB = (const char*)g.Bt + (size_t)cur.pn * tstep; const char* cX = (const char*)g.AX + (size_t)cur.pm * xstep;
    S.a_ready(cur);
    PG8_STAGE(PG8_SB(0, 0), cB, voffB); PG8_STAGE(PG8_SB(0, 1), cB + hstep, voffB); PG8_STAGE(PG8_SA(0, 0), cA, voffA); PG8_STAGEX(0, cX); PG8_STAGE(PG8_SA(0, 1), cA + hstep, voffA);
    if (wr == 1) PG8_BAR;
    PG8_WAIT_V(2); PG8_BAR;
    PG8_STAGE(PG8_SB(1, 0), cB + kstep, voffB); PG8_STAGE(PG8_SA(1, 0), cA + kstep, voffA); PG8_STAGE(PG8_SB(1, 1), cB + hstep + kstep, voffB); PG8_STAGEX(1, cX + kstep);
    PG8_WAIT_V(7); PG8_BAR;
    for (;;) {
        const bool has_next = S.next(ui + 1, nxt);
        const char* nA = has_next ? (const char*)g.A + (size_t)nxt.pm * tstep : cA; const char* nB = has_next ? (const char*)g.Bt + (size_t)nxt.pn * tstep : cB; const char* nX = has_next ? (const char*)g.AX + (size_t)nxt.pm * xstep : cX;
        for (int t = 0; t < nt; t += 2) {
            const bool last = (t == nt - 2);
            const char* a1 = cA + (size_t)(t + 1) * kstep;
            const char* a2 = last ? nA : cA + (size_t)(t + 2) * kstep; const char* b2 = last ? nB : cB + (size_t)(t + 2) * kstep; const char* x2 = last ? nX : cX + (size_t)(t + 2) * kstep;
            const char* a3 = a2 + kstep; const char* b3 = b2 + kstep; const char* x3 = x2 + kstep;
            if (last && has_next) S.a_ready(nxt);
            PG8_LDB(B0, 0, 0); PG8_LDB(B1, 0, 1); PG8_SCHED; PG8_LDA(At, 0, 0); PG8_LDX(0); PG8_STAGE(PG8_SA(1, 1), a1 + hstep, voffA);
            PG8_WAIT_V(9); PG8_WAIT_L(0); PG8_BAR; PG8_MMA(0, 0, At, B0); PG8_MMA(0, 1, At, B1); PG8_MMAX(); PG8_BAR; PG8_SCHED;
            PG8_LDA(At, 0, 1); PG8_STAGE(PG8_SB(0, 0), b2, voffB); PG8_STAGE(PG8_SB(0, 1), b2 + hstep, voffB); PG8_STAGE(PG8_SA(0, 0), a2, voffA); PG8_STAGEX(0, x2);
            PG8_WAIT_V(9); PG8_WAIT_L(0); PG8_BAR; PG8_MMA(1, 0, At, B0); PG8_MMA(1, 1, At, B1); PG8_BAR; PG8_SCHED;
            PG8_LDB(B0, 1, 0); PG8_LDB(B1, 1, 1); PG8_SCHED; PG8_LDA(At, 1, 0); PG8_LDX(1); PG8_STAGE(PG8_SA(0, 1), a2 + hstep, voffA);
            PG8_WAIT_V(9); PG8_WAIT_L(0); PG8_BAR; PG8_MMA(0, 0, At, B0); PG8_MMA(0, 1, At, B1); PG8_MMAX(); PG8_BAR; PG8_SCHED;
            PG8_LDA(At, 1, 1); PG8_STAGE(PG8_SB(1, 0), b3, voffB); PG8_STAGE(PG8_SB(1, 1), b3 + hstep, voffB); PG8_STAGE(PG8_SA(1, 0), a3, voffA); PG8_STAGEX(1, x3);
            PG8_WAIT_V(9); PG8_WAIT_L(0); PG8_BAR; PG8_MMA(1, 0, At, B0); PG8_MMA(1, 1, At, B1); PG8_BAR; PG8_SCHED;
        }
        if (wr == 0) PG8_BAR;
        E(acc, accx, cur, wr, wc, fr, fq); S.done(cur);
        if (!has_next) break;
#pragma unroll
        for (int a = 0; a < 2; ++a)
#pragma unroll
            for (int b = 0; b < 2; ++b)
#pragma unroll
                for (int m = 0; m < 4; ++m)
#pragma unroll
                    for (int n = 0; n < 2; ++n) acc[a][b][m][n] = (f32x4){0.f, 0.f, 0.f, 0.f};
        accx[0] = (f32x4){0.f, 0.f, 0.f, 0.f}; accx[1] = (f32x4){0.f, 0.f, 0.f, 0.f};
        cur = nxt; cA = nA; cB = nB; cX = nX; ++ui;
        if (wr == 1) PG8_BAR;
    }
    PG8_WAIT_V(0);
    PG8_BAR;
#undef PG8_SA
#undef PG8_SB
#undef PG8_SX
#undef PG8_STAGE
#undef PG8_STAGEX
#undef PG8_LDA
#undef PG8_LDB
#undef PG8_LDX
#undef PG8_MMA
#undef PG8_MMAX
#undef PG8_WAIT_V
#undef PG8_WAIT_L
#undef PG8_BAR
#undef PG8_SCHED
}
}

#ifndef MK_PER_PHASE
#define MK_PER_PHASE 0
#endif

constexpr int D = 2048, MP = 8192, MS = 512, M = MP + MS;
constexpr int SEQ = 2048, NBP = 4, NBS = 128, TS = 4, NCOND = NBP + NBS, DEPTH = 4;
constexpr int DFF = 8192;
constexpr int HG_H = 16, HG_K = 128, HG_V = 128;
constexpr int GL_H = 4, GL_K = 256, GL_V = 512, GL_KD = 1024, GL_R = 16, GL_IN = 6160, GL_INP = 6144;
constexpr int CH = 64, NCH = SEQ / CH;
constexpr float ALPHA = 1.6817928305074290f;
constexpr float LN_EPS = 1e-5f;

constexpr size_t O_YP = 0, O_YS = O_YP + (size_t)MP * D, O_HGP = O_YS + (size_t)MS * D, O_GLP = O_HGP + (size_t)2 * NBP * HG_H * HG_K * HG_V,
                 O_HGS = O_GLP + (size_t)2 * NBP * GL_H * GL_K * GL_V, O_GLS = O_HGS + (size_t)2 * NBS * HG_H * HG_K * HG_V, O_END = O_GLS + (size_t)2 * NBS * GL_H * GL_K * GL_V;

constexpr size_t al(size_t x) { return (x + 4095) & ~(size_t)4095; }
constexpr size_t WS_CTL = 0, CTL_ZERO_BYTES = 1u << 20;
constexpr size_t WS_HGWI = CTL_ZERO_BYTES;
constexpr size_t WS_HGWO = WS_HGWI + (size_t)2 * 8192 * 2048 * 2;
constexpr size_t WS_GLWI = WS_HGWO + (size_t)2 * 2048 * 2048 * 2;
constexpr size_t WS_GLWO = WS_GLWI + (size_t)2 * GL_INP * 2048 * 2;
constexpr size_t WS_WUP  = WS_GLWO + (size_t)2 * 2048 * 2048 * 2;
constexpr size_t WS_WDN  = WS_WUP + (size_t)4 * 8192 * 2048 * 2;
constexpr size_t WS_MOD  = WS_WDN + (size_t)4 * 8192 * 2048 * 2;
constexpr size_t WS_LB   = al(WS_MOD + (size_t)NCOND * 4 * 6 * D * 4);
constexpr size_t WS_CS   = al(WS_LB + (size_t)2 * D * 4);
constexpr size_t WS_X    = al(WS_CS + (size_t)144 * D * 2);
constexpr size_t WS_Z    = WS_X + (size_t)M * D * 4;
constexpr size_t WS_H    = WS_Z + (size_t)M * D * 4;
constexpr size_t WS_O    = WS_H + (size_t)M * D * 2;
constexpr size_t WS_QB   = WS_O + (size_t)M * D * 2;
constexpr size_t WS_KB   = WS_QB + (size_t)M * D * 2;
constexpr size_t WS_VB   = WS_KB + (size_t)M * D * 2;
constexpr size_t WS_GB   = WS_VB + (size_t)M * D * 2;
constexpr size_t WS_LF   = WS_GB + (size_t)M * D * 2;
constexpr size_t WS_U    = WS_LF + (size_t)M * D * 4;
constexpr size_t WS_ST   = WS_U + (size_t)M * DFF * 2;
constexpr size_t WS_ORAW = WS_ST + (size_t)NBP * GL_H * NCH * GL_V * GL_K * 2;
constexpr size_t WS_END  = WS_ORAW + (size_t)MS * D * 4;
constexpr int CW_TMO = 0, CW_BAR = 4096;

constexpr int LDS_BYTES = 163840, MISC_OFF = LDS_BYTES - 128;

#define GAS __attribute__((address_space(1)))
#define LAS __attribute__((address_space(3)))
typedef unsigned short bf16;
typedef unsigned v4u __attribute__((ext_vector_type(4)));
typedef unsigned v2u __attribute__((ext_vector_type(2)));
typedef float f32x4 __attribute__((ext_vector_type(4)));
typedef short bf16x8 __attribute__((ext_vector_type(8)));
typedef GAS unsigned gu32;
#define RLX_AGENT __ATOMIC_RELAXED, __HIP_MEMORY_SCOPE_AGENT
#define LDS_WAIT() asm volatile("s_waitcnt lgkmcnt(0)" ::: "memory")
#define VM_WAIT() asm volatile("s_waitcnt vmcnt(0)" ::: "memory")
__device__ __forceinline__ unsigned f2bf(float f) { unsigned u = __builtin_bit_cast(unsigned, f); return (u + 0x7fffu + ((u >> 16) & 1u)) >> 16; }
__device__ __forceinline__ unsigned pk2(float lo, float hi) { return f2bf(lo) | (f2bf(hi) << 16); }
__device__ __forceinline__ float bf2f(unsigned short b) { return __builtin_bit_cast(float, (unsigned)b << 16); }
__device__ __forceinline__ float bflo(unsigned w) { return __builtin_bit_cast(float, w << 16); }
__device__ __forceinline__ float bfhi(unsigned w) { return __builtin_bit_cast(float, w & 0xffff0000u); }
__device__ __forceinline__ float fast_exp(float x) { return __builtin_amdgcn_exp2f(x * 1.4426950408889634f); }
__device__ __forceinline__ float fast_log(float x) { return __builtin_amdgcn_logf(x) * 0.6931471805599453f; }
__device__ __forceinline__ float silu_f(float v) { return v * __builtin_amdgcn_rcpf(1.0f + fast_exp(-v)); }
__device__ __forceinline__ float logsigmoid_f(float x) { return fminf(x, 0.f) - fast_log(1.0f + fast_exp(-fabsf(x))); }
__device__ __forceinline__ float wave_sum(float v) {
#pragma unroll
    for (int o = 1; o < 64; o <<= 1) v += __shfl_xor(v, o);
    return v;
}
__device__ __forceinline__ int cond_of_row(int r) { return r < MP ? (r >> 11) : NBP + ((r - MP) >> 2); }

#define XB_TMO      128
#define XB_XCNT(j)  (256  + 64 * (j))
#define XB_XSUB(j)  (1280 + 64 * (j))
#define XB_XGEN(j)  (2304 + 64 * (j))
#define XB_TOP      3328
#define XB_TOPGEN   3392
#define XCD_BAR_WORDS 3456
#define XB_SPIN_CAP (1u << 18)
#define LAS __attribute__((address_space(3)))

__device__ __forceinline__ unsigned xb_ld(unsigned* p)              { return __hip_atomic_load(p, __ATOMIC_RELAXED, __HIP_MEMORY_SCOPE_AGENT); }
__device__ __forceinline__ unsigned xb_add(unsigned* p, unsigned v) { return __hip_atomic_fetch_add(p, v, __ATOMIC_RELAXED, __HIP_MEMORY_SCOPE_AGENT); }
__device__ __forceinline__ unsigned xb_xcc_id() { return (unsigned)__builtin_amdgcn_s_getreg((3 << 11) | 20) & 0xFu; }
#define XB_SPIN(cond, bar) do { unsigned _sp = 0; while (cond) { __builtin_amdgcn_s_sleep(1); \
    if ((++_sp & 255u) == 0u) { if (xb_ld(&(bar)[XB_TMO])) break; if (_sp > XB_SPIN_CAP) { atomicAdd(&(bar)[XB_TMO], 1u); break; } } } } while (0)

struct XcdBarrier {
    unsigned* bar; unsigned x;
    volatile LAS unsigned* st;
};

__device__ __forceinline__ XcdBarrier xcd_barrier_post(unsigned* bar, volatile LAS unsigned* st) {
    XcdBarrier b; b.bar = bar; b.x = xb_xcc_id(); b.st = st;
    if (threadIdx.x == 0) (void)xb_add(&bar[XB_XCNT(b.x)], 1u);
    return b;
}
__device__ __forceinline__ void xcd_barrier_complete(unsigned* bar, unsigned x, unsigned& nloc, unsigned& nx) {
    const unsigned G = gridDim.x * gridDim.y * gridDim.z;
    unsigned sum, cnt, mine, sp = 0u;
    for (;;) {
        sum = 0u; cnt = 0u; mine = 0u;
#pragma unroll
        for (unsigned j = 0; j < 16; ++j) { const unsigned c = xb_ld(&bar[XB_XCNT(j)]); sum += c; cnt += (c > 0u) ? 1u : 0u; mine = (j == x) ? c : mine; }
        if (sum == G) break;
        __builtin_amdgcn_s_sleep(1);
        if ((++sp & 255u) == 0u) { if (xb_ld(&bar[XB_TMO])) break; if (sp > XB_SPIN_CAP) { atomicAdd(&bar[XB_TMO], 1u); break; } }
    }
    nloc = mine > 0u ? mine : 1u; nx = cnt > 0u ? cnt : 1u;
}

__device__ __forceinline__ void xcd_barrier(const XcdBarrier& b) {
    asm volatile("s_waitcnt vmcnt(0)" ::: "memory");
    __syncthreads();
    if (threadIdx.x == 0) {
        unsigned* bar = b.bar;
        __builtin_amdgcn_s_waitcnt(0);
        unsigned nloc = b.st[0], nx = b.st[1];
        if (nloc == 0u) { xcd_barrier_complete(bar, b.x, nloc, nx); b.st[0] = nloc; b.st[1] = nx; }
        const unsigned old = xb_add(&bar[XB_XSUB(b.x)], 1u);
        const unsigned gen = old / nloc;
        if (old + 1u == (gen + 1u) * nloc) {
            __builtin_amdgcn_fence(__ATOMIC_RELEASE, "agent");
            asm volatile("s_waitcnt vmcnt(0)" ::: "memory");
            const unsigned og = xb_add(&bar[XB_TOP], 1u);
            const unsigned tg = og / nx;
            if (og + 1u == (tg + 1u) * nx) xb_add(&bar[XB_TOPGEN], 1u);
            else XB_SPIN(xb_ld(&bar[XB_TOPGEN]) == tg, bar);
            __builtin_amdgcn_fence(__ATOMIC_ACQUIRE, "agent");
            xb_add(&bar[XB_XGEN(b.x)], 1u);
            asm volatile("s_waitcnt vmcnt(0)" ::: "memory");
        } else {
            XB_SPIN(xb_ld(&bar[XB_XGEN(b.x)]) == gen, bar);
            __builtin_amdgcn_fence(__ATOMIC_ACQUIRE, "agent");
            asm volatile("s_waitcnt vmcnt(0)" ::: "memory");
        }
    }
    __syncthreads();
}

using pg8::cvt_pk_bf16;

struct EpiHgIn {
    static constexpr bool PERM = true, AFTER_DRAIN = false;
    bf16 *QB; float* LF; const float* lb;
    __device__ __forceinline__ void put_f(int row, int c, const f32x4& a0, const f32x4& a1, const f32x4& l0, const f32x4& l1) const {
        const size_t off = (size_t)row * D + c;
        const float fpv[8] = {a0[0], a0[1], a0[2], a0[3], a1[0], a1[1], a1[2], a1[3]};
        const float lbs[8] = {l0[0], l0[1], l0[2], l0[3], l1[0], l1[1], l1[2], l1[3]};
        float lf[8], kk[8];
#pragma unroll
        for (int i = 0; i < 8; ++i) {
            const float fp = fpv[i], lbv = lbs[i];
            const float e = fast_exp(-fabsf(fp)), inv = __builtin_amdgcn_rcpf(1.0f + e);
            const float sig = fp >= 0.f ? inv : e * inv, nsig = fp >= 0.f ? e * inv : inv;
            const float ls = fminf(fp, 0.f) - fast_log(1.0f + e);
            lf[i] = lbv > 0.f ? fast_log(lbv + (1.0f - lbv) * sig) : ls;
            kk[i] = (1.0f - lbv) * nsig;
        }
        *(f32x4*)(LF + off) = (f32x4){lf[0], lf[1], lf[2], lf[3]};
        *(f32x4*)(LF + off + 4) = (f32x4){lf[4], lf[5], lf[6], lf[7]};
        v4u w; w.x = cvt_pk_bf16(kk[0], kk[1]); w.y = cvt_pk_bf16(kk[2], kk[3]); w.z = cvt_pk_bf16(kk[4], kk[5]); w.w = cvt_pk_bf16(kk[6], kk[7]);
        *(v4u*)(QB + (size_t)M * D + off) = w;
    }
    __device__ __forceinline__ void put_o(bf16* dst, bool act, int row, int c, const f32x4& a0, const f32x4& a1) const {
        const float v[8] = {a0[0], a0[1], a0[2], a0[3], a1[0], a1[1], a1[2], a1[3]};
        float x[8];
#pragma unroll
        for (int i = 0; i < 8; ++i) x[i] = act ? silu_f(v[i]) : v[i];
        v4u w; w.x = cvt_pk_bf16(x[0], x[1]); w.y = cvt_pk_bf16(x[2], x[3]); w.z = cvt_pk_bf16(x[4], x[5]); w.w = cvt_pk_bf16(x[6], x[7]);
        *(v4u*)(dst + (size_t)row * D + c) = w;
    }
    __device__ __forceinline__ void operator()(const pg8::f32x4 (&acc)[2][2][4][2], const pg8::f32x4 (&accx)[2], const pg8::Unit& u, int wr, int wc, int fr, int fq) const {
        const int row0 = u.pm * 256 + wr * 64 + fr, sec = u.pn >> 3, col0 = (u.pn & 7) * 256 + wc * 32 + 8 * fq, rowx = MP + u.pm * 16 + fr;
        if (sec == 1) {
#pragma unroll
            for (int bj = 0; bj < 2; ++bj) {
                const int c = col0 + bj * 128;
                const f32x4 l0 = *(const f32x4*)(lb + c), l1 = *(const f32x4*)(lb + c + 4);
#pragma unroll
                for (int ai = 0; ai < 2; ++ai)
#pragma unroll
                    for (int m = 0; m < 4; ++m) put_f(row0 + ai * 128 + m * 16, c, acc[ai][bj][m][0], acc[ai][bj][m][1], l0, l1);
            }
            { const int c = col0 + wr * 128; const f32x4 l0 = *(const f32x4*)(lb + c), l1 = *(const f32x4*)(lb + c + 4); put_f(rowx, c, accx[0], accx[1], l0, l1); }
        } else {
            bf16* dst = QB + (size_t)sec * ((size_t)M * D);
            const bool act = sec != 2;
#pragma unroll
            for (int ai = 0; ai < 2; ++ai)
#pragma unroll
                for (int m = 0; m < 4; ++m)
#pragma unroll
                    for (int bj = 0; bj < 2; ++bj) put_o(dst, act, row0 + ai * 128 + m * 16, col0 + bj * 128, acc[ai][bj][m][0], acc[ai][bj][m][1]);
            put_o(dst, act, rowx, col0 + wr * 128, accx[0], accx[1]);
        }
    }
};

struct EpiGlaIn {
    static constexpr bool PERM = true, AFTER_DRAIN = false;
    bf16 *QB;
    __device__ __forceinline__ void put_o(bf16* dst, int ld, bool act, float sc, int row, int c, const f32x4& a0, const f32x4& a1) const {
        const float v[8] = {a0[0], a0[1], a0[2], a0[3], a1[0], a1[1], a1[2], a1[3]};
        float x[8];
#pragma unroll
        for (int i = 0; i < 8; ++i) x[i] = act ? silu_f(v[i]) : v[i] * sc;
        v4u w; w.x = cvt_pk_bf16(x[0], x[1]); w.y = cvt_pk_bf16(x[2], x[3]); w.z = cvt_pk_bf16(x[4], x[5]); w.w = cvt_pk_bf16(x[6], x[7]);
        *(v4u*)(dst + (size_t)row * ld + c) = w;
    }
    __device__ __forceinline__ void operator()(const pg8::f32x4 (&acc)[2][2][4][2], const pg8::f32x4 (&accx)[2], const pg8::Unit& u, int wr, int wc, int fr, int fq) const {
        const int row0 = u.pm * 256 + wr * 64 + fr, pn = u.pn, rowx = MP + u.pm * 16 + fr;
        int which, ld, colt; float sc = 1.f; bool act = false;
        if (pn < 4) { which = 0; ld = GL_KD; colt = pn * 256; sc = 0.0625f; }
        else if (pn < 8) { which = 1; ld = GL_KD; colt = (pn - 4) * 256; }
        else if (pn < 16) { which = 2; ld = D; colt = (pn - 8) * 256; }
        else { which = 3; ld = D; colt = (pn - 16) * 256; act = true; }
        bf16* dst = QB + (size_t)which * ((size_t)M * D);
        const int col0 = colt + wc * 32 + 8 * fq;
#pragma unroll
        for (int ai = 0; ai < 2; ++ai)
#pragma unroll
            for (int m = 0; m < 4; ++m)
#pragma unroll
                for (int bj = 0; bj < 2; ++bj) put_o(dst, ld, act, sc, row0 + ai * 128 + m * 16, col0 + bj * 128, acc[ai][bj][m][0], acc[ai][bj][m][1]);
        put_o(dst, ld, act, sc, rowx, col0 + wr * 128, accx[0], accx[1]);
    }
};

struct EpiUp {
    static constexpr bool PERM = true, AFTER_DRAIN = false;
    bf16* U;
    __device__ __forceinline__ void put_o(int row, int c, const f32x4& a0, const f32x4& a1) const {
        const float v[8] = {a0[0], a0[1], a0[2], a0[3], a1[0], a1[1], a1[2], a1[3]};
        float x[8];
#pragma unroll
        for (int i = 0; i < 8; ++i) { const float r = fmaxf(v[i], 0.f); x[i] = r * r; }
        v4u w; w.x = cvt_pk_bf16(x[0], x[1]); w.y = cvt_pk_bf16(x[2], x[3]); w.z = cvt_pk_bf16(x[4], x[5]); w.w = cvt_pk_bf16(x[6], x[7]);
        *(v4u*)(U + (size_t)row * DFF + c) = w;
    }
    __device__ __forceinline__ void operator()(const pg8::f32x4 (&acc)[2][2][4][2], const pg8::f32x4 (&accx)[2], const pg8::Unit& u, int wr, int wc, int fr, int fq) const {
        const int row0 = u.pm * 256 + wr * 64 + fr, col0 = u.pn * 256 + wc * 32 + 8 * fq;
#pragma unroll
        for (int ai = 0; ai < 2; ++ai)
#pragma unroll
            for (int m = 0; m < 4; ++m)
#pragma unroll
                for (int bj = 0; bj < 2; ++bj) put_o(row0 + ai * 128 + m * 16, col0 + bj * 128, acc[ai][bj][m][0], acc[ai][bj][m][1]);
        put_o(MP + u.pm * 16 + fr, col0 + wr * 128, accx[0], accx[1]);
    }
};

struct EpiRes {
    static constexpr bool PERM = false, AFTER_DRAIN = false;
    const float* X; float* Z; const float* gate;
    __device__ __forceinline__ void put(int row, int c, const f32x4& a) const {
        const f32x4 gv = *(const f32x4*)(gate + (size_t)cond_of_row(row) * (4 * 6 * D) + c), xv = *(const f32x4*)(X + (size_t)row * D + c);
        *(f32x4*)(Z + (size_t)row * D + c) = xv * ALPHA + (gv + 1.0f) * a;
    }
    __device__ __forceinline__ void operator()(const pg8::f32x4 (&acc)[2][2][4][2], const pg8::f32x4 (&accx)[2], const pg8::Unit& u, int wr, int wc, int fr, int fq) const {
        const int row0 = u.pm * 256 + wr * 64 + fr, col0 = u.pn * 256 + wc * 32 + 4 * fq;
#pragma unroll
        for (int ai = 0; ai < 2; ++ai)
#pragma unroll
            for (int m = 0; m < 4; ++m)
#pragma unroll
                for (int bj = 0; bj < 2; ++bj)
#pragma unroll
                    for (int n = 0; n < 2; ++n) put(row0 + ai * 128 + m * 16, col0 + bj * 128 + n * 16, acc[ai][bj][m][n]);
#pragma unroll
        for (int n = 0; n < 2; ++n) put(MP + u.pm * 16 + fr, col0 + wr * 128 + n * 16, accx[n]);
    }
};

struct Args { const float* in[21]; float* out; unsigned char* ws; int ph_lo, ph_hi; };
typedef const __attribute__((address_space(4))) Args* KArgs;
struct Frame {
    LAS unsigned char* lds;
    volatile LAS unsigned* MISC;
    int tid, lane, wave;
    int vcu, G, bx;
    unsigned char* ws;
    KArgs ka;
    float* out;
};
constexpr int NWAVES = 8, NT = 512;
__device__ __forceinline__ Frame mk_frame() {
    extern __shared__ __attribute__((aligned(16))) unsigned char lds_base[];
    Frame F;
    int tid = threadIdx.x; asm volatile("" : "+v"(tid));
    int bx = blockIdx.x, G = gridDim.x; asm volatile("" : "+s"(bx), "+s"(G));
    KArgs ka = (KArgs)__builtin_amdgcn_kernarg_segment_ptr(); asm volatile("" : "+s"(ka));
    F.lds = (LAS unsigned char*)lds_base; F.MISC = (volatile LAS unsigned*)(F.lds + MISC_OFF);
    F.tid = tid; F.lane = tid & 63; F.wave = __builtin_amdgcn_readfirstlane(tid >> 6);
    F.G = G; F.bx = bx; F.vcu = (G % 8 == 0) ? (bx % 8) * (G / 8) + bx / 8 : bx;
    F.ka = ka; F.ws = ka->ws; F.out = ka->out;
    return F;
}

__device__ __forceinline__ void p0_transpose_item(const float* W, int K, int ld, int ncols, bf16* WT, LAS float* scr, int item, int lane) {
    const int nblk = ncols / 32, kb = item / nblk, nb = item % nblk, k0 = 64 * kb, n0 = 32 * nb;
#pragma unroll 8
    for (int i = 0; i < 32; ++i) { const int kk = 2 * i + (lane >> 5); scr[kk * 33 + (lane & 31)] = W[(size_t)(k0 + kk) * ld + n0 + (lane & 31)]; }
    LDS_WAIT(); asm volatile("" ::: "memory");
    const int c = lane & 7;
#pragma unroll
    for (int j = 0; j < 4; ++j) { const int n = (lane >> 3) + 8 * j; const LAS float* s = scr + (8 * c) * 33 + n;
        v4u o; o.x = pk2(s[0 * 33], s[1 * 33]); o.y = pk2(s[2 * 33], s[3 * 33]); o.z = pk2(s[4 * 33], s[5 * 33]); o.w = pk2(s[6 * 33], s[7 * 33]);
        *(GAS v4u*)(WT + (size_t)(n0 + n) * K + k0 + 8 * c) = o; }
    LDS_WAIT(); asm volatile("" ::: "memory");
}

__device__ __forceinline__ void phase_p0(Frame& F) {
    const int gt = F.vcu * NT + F.tid, NGT = F.G * NT;
    bf16* CS = (bf16*)(F.ws + WS_CS);
    for (int i = gt; i < 144 * D; i += NGT) {
        const int r = i / D, c = i % D; float v = 0.f;
        if (r < NBP) v = F.ka->in[4][(size_t)r * D + c]; else if (r < NCOND) v = F.ka->in[5][(size_t)(r - NBP) * D + c];
        CS[i] = (bf16)f2bf(r < NCOND ? silu_f(v) : 0.f);
    }
    float* LB = (float*)(F.ws + WS_LB);
    for (int c = gt; c < D; c += NGT) {
        const float a0 = F.ka->in[11][c], a1 = F.ka->in[11][D + c], mx = fmaxf(a0, a1);
        const float e0 = expf(a0 - mx), e1 = expf(a1 - mx), s = e0 + e1, p0 = e0 / s, p1 = e1 / s;
        LB[c] = fminf(fmaxf(p0 - p0, 0.f), 1.0f - 1e-6f);
        LB[D + c] = fminf(fmaxf((p0 + p1) - p0, 0.f), 1.0f - 1e-6f);
    }
}

__device__ __forceinline__ void phase_p1(Frame& F) {
    {
        const bf16* CS = (const bf16*)(F.ws + WS_CS);
        float* MOD = (float*)(F.ws + WS_MOD);
        const int fr = F.lane & 15, fq = F.lane >> 4, nt = F.wave & 3, kh = F.wave >> 2;
        LAS float* red = (LAS float*)F.lds;
        for (int it = F.vcu; it < (DEPTH * 6 * D) / 64; it += F.G) {
            const int nn = it * 64, l = nn / (6 * D), c0 = nn % (6 * D) + 16 * nt;
            const float* W = F.ka->in[6] + (size_t)l * D * (6 * D) + c0 + fr;
            f32x4 acc[9];
#pragma unroll
            for (int rt = 0; rt < 9; ++rt) acc[rt] = (f32x4){0.f, 0.f, 0.f, 0.f};
            for (int ks = 0; ks < 32; ++ks) {
                const int k0 = kh * 1024 + ks * 32 + 8 * fq;
                float w[8];
#pragma unroll
                for (int j = 0; j < 8; ++j) w[j] = W[(size_t)(k0 + j) * (6 * D)];
                v4u bw; bw.x = pk2(w[0], w[1]); bw.y = pk2(w[2], w[3]); bw.z = pk2(w[4], w[5]); bw.w = pk2(w[6], w[7]);
                const bf16x8 bfrag = __builtin_bit_cast(bf16x8, bw);
#pragma unroll
                for (int rt = 0; rt < 9; ++rt) {
                    const bf16x8 afrag = *(const bf16x8*)(CS + (size_t)(16 * rt + fr) * D + k0);
                    acc[rt] = __builtin_amdgcn_mfma_f32_16x16x32_bf16(afrag, bfrag, acc[rt], 0, 0, 0);
                }
            }
            if (kh == 1) {
#pragma unroll
                for (int rt = 0; rt < 9; ++rt) *(LAS f32x4*)(red + ((nt * 9 + rt) * 64 + F.lane) * 4) = acc[rt];
            }
            __syncthreads();
            if (kh == 0) {
                const float bias = F.ka->in[7][(size_t)l * (6 * D) + c0 + fr];
#pragma unroll
                for (int rt = 0; rt < 9; ++rt) {
                    const f32x4 o = acc[rt] + *(LAS f32x4*)(red + ((nt * 9 + rt) * 64 + F.lane) * 4);
#pragma unroll
                    for (int j = 0; j < 4; ++j) { const int row = 16 * rt + 4 * fq + j; if (row < NCOND) MOD[((size_t)row * DEPTH + l) * (6 * D) + c0 + fr] = o[j] + bias; }
                }
            }
            __syncthreads();
        }
    }
    LAS float* scr = (LAS float*)(F.lds + F.wave * 16384);
    const int gw = F.vcu * NWAVES + F.wave, NGW = F.G * NWAVES;
    constexpr int I_HGI = 32 * 256, I_SQ = 32 * 64, I_GLI = 32 * 192, I_UP = 32 * 256, I_DN = 128 * 64;
    constexpr int NITEMS = 2 * (I_HGI + I_SQ + I_GLI + I_SQ) + 4 * (I_UP + I_DN);
    for (int it = gw; it < NITEMS; it += NGW) {
        int r = it;
        if (r < 2 * I_HGI) { const int j = r / I_HGI; p0_transpose_item(F.ka->in[10] + (size_t)j * D * 8192, D, 8192, 8192, (bf16*)(F.ws + WS_HGWI) + (size_t)j * 8192 * D, scr, r % I_HGI, F.lane); continue; } r -= 2 * I_HGI;
        if (r < 2 * I_SQ) { const int j = r / I_SQ; p0_transpose_item(F.ka->in[13] + (size_t)j * D * D, D, D, D, (bf16*)(F.ws + WS_HGWO) + (size_t)j * D * D, scr, r % I_SQ, F.lane); continue; } r -= 2 * I_SQ;
        if (r < 2 * I_GLI) { const int j = r / I_GLI; p0_transpose_item(F.ka->in[14] + (size_t)j * D * GL_IN, D, GL_IN, 6144, (bf16*)(F.ws + WS_GLWI) + (size_t)j * GL_INP * D, scr, r % I_GLI, F.lane); continue; } r -= 2 * I_GLI;
        if (r < 2 * I_SQ) { const int j = r / I_SQ; p0_transpose_item(F.ka->in[18] + (size_t)j * D * D, D, D, D, (bf16*)(F.ws + WS_GLWO) + (size_t)j * D * D, scr, r % I_SQ, F.lane); continue; } r -= 2 * I_SQ;
        if (r < 4 * I_UP) { const int l = r / I_UP; p0_transpose_item(F.ka->in[19] + (size_t)l * D * DFF, D, DFF, DFF, (bf16*)(F.ws + WS_WUP) + (size_t)l * DFF * D, scr, r % I_UP, F.lane); continue; } r -= 4 * I_UP;
        { const int l = r / I_DN; p0_transpose_item(F.ka->in[20] + (size_t)l * DFF * D, DFF, D, D, (bf16*)(F.ws + WS_WDN) + (size_t)l * D * DFF, scr, r % I_DN, F.lane); }
    }
}

__device__ __forceinline__ void row_load(const float* p, int lane, f32x4 (&v)[8]) {
    const GAS f32x4* xr = (const GAS f32x4*)p + lane;
#pragma unroll
    for (int j = 0; j < 8; ++j) v[j] = xr[64 * j];
}
__device__ __forceinline__ void row_modulate_store(const f32x4 (&x)[8], const float* sc, const float* sh, bf16* hrow, int lane) {
    GAS v2u* o8 = (GAS v2u*)hrow + lane;
#pragma unroll
    for (int j = 0; j < 8; ++j) {
        const f32x4 s = *((const GAS f32x4*)sc + lane + 64 * j), b = *((const GAS f32x4*)sh + lane + 64 * j);
        const f32x4 h = x[j] * (s + 1.0f) + b;
        v2u w; w.x = pk2(h[0], h[1]); w.y = pk2(h[2], h[3]); o8[64 * j] = w;
    }
}
__device__ __forceinline__ void phase_p2(Frame& F) {
    const int gw = F.vcu * NWAVES + F.wave, NGW = F.G * NWAVES;
    float* X = (float*)(F.ws + WS_X); bf16* H = (bf16*)(F.ws + WS_H); const float* MOD = (const float*)(F.ws + WS_MOD);
    for (int r = gw; r < M; r += NGW) {
        const float* src = r < MP ? F.ka->in[0] + (size_t)r * D : F.ka->in[1] + (size_t)(r - MP) * D;
        f32x4 v[8]; row_load(src, F.lane, v);
        GAS f32x4* xo = (GAS f32x4*)(X + (size_t)r * D) + F.lane;
#pragma unroll
        for (int j = 0; j < 8; ++j) xo[64 * j] = v[j];
        const float* md = MOD + (size_t)cond_of_row(r) * (DEPTH * 6 * D);
        row_modulate_store(v, md + D, md, H + (size_t)r * D, F.lane);
    }
}
template <bool GKL> __device__ __forceinline__ void phase_ln(Frame& F, const float* lnw, const float* lnb, int sc_off, int sh_off, bool last, int jg) {
    const int gw = F.vcu * NWAVES + F.wave, NGW = F.G * NWAVES, lane = F.lane;
    const float* Z = (const float*)(F.ws + WS_Z); float* X = (float*)(F.ws + WS_X); bf16* H = (bf16*)(F.ws + WS_H); const float* MOD = (const float*)(F.ws + WS_MOD);
    LAS bf16* WgL = (LAS bf16*)F.lds; LAS float* W2 = (LAS float*)(F.lds + 65536);
    const float* bgk = nullptr; float* LFo = nullptr;
    if constexpr (GKL) {
        const float* Wg = F.ka->in[14] + (size_t)jg * D * GL_IN + 6144;
        for (int i = F.tid; i < D * 16; i += NT) { const int k = i >> 4, r = i & 15, l = (k & 255) >> 2, e = k & 3, j = k >> 8; WgL[(((j * 4 + e) * 64) + l) * 16 + r] = (bf16)f2bf(Wg[(size_t)k * GL_IN + r]); }
        const float* w2 = F.ka->in[15] + (size_t)jg * GL_R * GL_KD;
        for (int i = F.tid; i < GL_R * GL_KD; i += NT) W2[i] = w2[i];
        bgk = F.ka->in[16] + (size_t)jg * GL_KD; LFo = (float*)(F.ws + WS_LF);
        __syncthreads();
    }
    for (int r = gw; r < M; r += NGW) {
        f32x4 v[8]; row_load(Z + (size_t)r * D, lane, v);
        float s = 0.f;
#pragma unroll
        for (int j = 0; j < 8; ++j) s += (v[j][0] + v[j][1]) + (v[j][2] + v[j][3]);
        const float mean = wave_sum(s) * (1.0f / D); float s2 = 0.f;
#pragma unroll
        for (int j = 0; j < 8; ++j) { v[j] = v[j] - mean; s2 += (v[j][0] * v[j][0] + v[j][1] * v[j][1]) + (v[j][2] * v[j][2] + v[j][3] * v[j][3]); }
        const float rstd = 1.0f / sqrtf(wave_sum(s2) * (1.0f / D) + LN_EPS);
#pragma unroll
        for (int j = 0; j < 8; ++j) {
            const f32x4 w = *((const GAS f32x4*)lnw + lane + 64 * j), b = *((const GAS f32x4*)lnb + lane + 64 * j);
            v[j] = v[j] * rstd * w + b;
        }
        float* dst = last ? (r < MP ? F.out + O_YP + (size_t)r * D : F.out + O_YS + (size_t)(r - MP) * D) : X + (size_t)r * D;
        GAS f32x4* xo = (GAS f32x4*)dst + lane;
#pragma unroll
        for (int j = 0; j < 8; ++j) xo[64 * j] = v[j];
        if (!last) {
            const float* md = MOD + (size_t)cond_of_row(r) * (DEPTH * 6 * D);
            const float* sc = md + sc_off; const float* sh = md + sh_off;
            GAS v2u* o8 = (GAS v2u*)(H + (size_t)r * D) + lane;
            float p[16];
#pragma unroll
            for (int q = 0; q < 16; ++q) p[q] = 0.f;
#pragma unroll
            for (int j = 0; j < 8; ++j) {
                const f32x4 sv = *((const GAS f32x4*)sc + lane + 64 * j), bv = *((const GAS f32x4*)sh + lane + 64 * j);
                const f32x4 h = v[j] * (sv + 1.0f) + bv;
                v2u w; w.x = pk2(h[0], h[1]); w.y = pk2(h[2], h[3]); o8[64 * j] = w;
                if constexpr (GKL) {
#pragma unroll
                    for (int e = 0; e < 4; ++e) {
                        const LAS v4u* wp = (const LAS v4u*)(WgL + (((j * 4 + e) * 64) + lane) * 16);
                        const v4u w0 = wp[0], w1 = wp[1];
                        const float hv = h[e];
                        p[0] += hv * bflo(w0.x); p[1] += hv * bfhi(w0.x); p[2] += hv * bflo(w0.y); p[3] += hv * bfhi(w0.y);
                        p[4] += hv * bflo(w0.z); p[5] += hv * bfhi(w0.z); p[6] += hv * bflo(w0.w); p[7] += hv * bfhi(w0.w);
                        p[8] += hv * bflo(w1.x); p[9] += hv * bfhi(w1.x); p[10] += hv * bflo(w1.y); p[11] += hv * bfhi(w1.y);
                        p[12] += hv * bflo(w1.z); p[13] += hv * bfhi(w1.z); p[14] += hv * bflo(w1.w); p[15] += hv * bfhi(w1.w);
                    }
                    asm volatile("" : "+v"(p[0]), "+v"(p[1]), "+v"(p[2]), "+v"(p[3]), "+v"(p[4]), "+v"(p[5]), "+v"(p[6]), "+v"(p[7]), "+v"(p[8]), "+v"(p[9]), "+v"(p[10]), "+v"(p[11]), "+v"(p[12]), "+v"(p[13]), "+v"(p[14]), "+v"(p[15]) :: "memory");
                }
            }
            if constexpr (GKL) {
#pragma unroll
                for (int q = 0; q < 16; ++q) p[q] = wave_sum(p[q]);
#pragma unroll
                for (int e2 = 0; e2 < 16; ++e2) {
                    const int c = lane + 64 * e2;
                    float x = bgk[c];
#pragma unroll
                    for (int q = 0; q < 16; ++q) x += p[q] * W2[q * GL_KD + c];
                    asm volatile("" : "+v"(x) :: "memory");
                    LFo[(size_t)r * GL_KD + c] = logsigmoid_f(x) * 0.0625f;
                }
            }
        }
    }
}

template <bool GLA> struct RecCfg {
    static constexpr int K = GLA ? GL_K : HG_K, V = GLA ? GL_V : HG_V, H = GLA ? GL_H : HG_H;
    static constexpr int LDQK = GLA ? GL_KD : D;
    static constexpr int LDLF = GLA ? GL_KD : D;
    static constexpr int SSEG = NT / K, L = CH / SSEG;
    static constexpr int KP = K + 8;
    static constexpr int SP = CH + 8;
};
struct RecArgs {
    const bf16 *QB, *KB, *VB, *GB; const float* LF;
    bf16* O; bf16* ST; float* ORAW;
    const float* normw;
    const float* s_in; float* s_out_sample; float* s_out_prompt;
};
__device__ __forceinline__ float clamp_exp(float x) { return fast_exp(fminf(x, 80.f)); }

template <bool GLA> __device__ __forceinline__ void rec_pass_a(Frame& F, const RecArgs& A) {
    typedef RecCfg<GLA> C; constexpr int K = C::K, V = C::V, H = C::H, LDQK = C::LDQK, LDLF = C::LDLF;
    constexpr int KS = K / 16, VQ = V / 128, NSI = NBP * H * KS * VQ;
    constexpr int CPL = GLA ? 4 : 2, VWS = 64 * CPL, VP = V / VWS, NST = NBS * H * VP, KPL = K / 64;
    const int lane = F.lane, wave = F.wave, fr = lane & 15, fq = lane >> 4;
    LAS unsigned* cnt = (LAS unsigned*)F.lds;
    LAS float* vec = (LAS float*)(F.lds + 1024 + wave * 12288);
    if (F.tid == 0) *cnt = 0u;
    __syncthreads();
#ifndef REP_SCAN
#define REP_SCAN 1
#endif
#ifndef REP_STREAM
#define REP_STREAM 1
#endif
    _Pragma("nounroll") for (int rep_s = 0; rep_s < REP_SCAN; ++rep_s)
    for (int it = F.vcu + F.G * wave; it < NSI; it += F.G * NWAVES) {
        const int vq = it % VQ, ks = (it / VQ) % KS, h = (it / (VQ * KS)) % H, b = it / (VQ * KS * H);
        const int kcol = h * K + 16 * ks + fr;
        const int vcol = h * V + vq * 128 + 8 * fr;
        f32x4 S[8];
#pragma unroll
        for (int i = 0; i < 8; ++i) S[i] = (f32x4){0.f, 0.f, 0.f, 0.f};
        bf16* STi = A.ST + (size_t)((b * H + h) * NCH) * V * K + ((size_t)ks * V + vq * 128 + 8 * fr) * 16 + 4 * fq;
        for (int c = 0; c < NCH; ++c) {
            const int R0 = b * SEQ + c * CH + 8 * fq;
            float l0[8], l1[8], k0[8], k1[8]; v4u vr0[8], vr1[8];
#pragma unroll
            for (int i = 0; i < 8; ++i) {
                l0[i] = A.LF[(size_t)(R0 + i) * LDLF + kcol]; l1[i] = A.LF[(size_t)(R0 + 32 + i) * LDLF + kcol];
                k0[i] = bf2f(A.KB[(size_t)(R0 + i) * LDQK + kcol]); k1[i] = bf2f(A.KB[(size_t)(R0 + 32 + i) * LDQK + kcol]);
                vr0[i] = *(const v4u*)(A.VB + (size_t)(R0 + i) * D + vcol); vr1[i] = *(const v4u*)(A.VB + (size_t)(R0 + 32 + i) * D + vcol);
            }
#pragma unroll
            for (int i = 1; i < 8; ++i) { l0[i] += l0[i - 1]; l1[i] += l1[i - 1]; }
            float t0[4], t1[4];
#pragma unroll
            for (int f = 0; f < 4; ++f) { t0[f] = __shfl(l0[7], fr + 16 * f); t1[f] = __shfl(l1[7], fr + 16 * f); }
            const float rr = (t0[0] + t0[1]) + (t0[2] + t0[3]);
            float pre0 = 0.f, pre1 = rr;
#pragma unroll
            for (int f = 0; f < 3; ++f) if (f < fq) { pre0 += t0[f]; pre1 += t1[f]; }
            const float bl = rr + ((t1[0] + t1[1]) + (t1[2] + t1[3]));
            v4u a0, a1;
            a0.x = pk2(k0[0] * clamp_exp(rr - (pre0 + l0[0])), k0[1] * clamp_exp(rr - (pre0 + l0[1])));
            a0.y = pk2(k0[2] * clamp_exp(rr - (pre0 + l0[2])), k0[3] * clamp_exp(rr - (pre0 + l0[3])));
            a0.z = pk2(k0[4] * clamp_exp(rr - (pre0 + l0[4])), k0[5] * clamp_exp(rr - (pre0 + l0[5])));
            a0.w = pk2(k0[6] * clamp_exp(rr - (pre0 + l0[6])), k0[7] * clamp_exp(rr - (pre0 + l0[7])));
            a1.x = pk2(k1[0] * clamp_exp(rr - (pre1 + l1[0])), k1[1] * clamp_exp(rr - (pre1 + l1[1])));
            a1.y = pk2(k1[2] * clamp_exp(rr - (pre1 + l1[2])), k1[3] * clamp_exp(rr - (pre1 + l1[3])));
            a1.z = pk2(k1[4] * clamp_exp(rr - (pre1 + l1[4])), k1[5] * clamp_exp(rr - (pre1 + l1[5])));
            a1.w = pk2(k1[6] * clamp_exp(rr - (pre1 + l1[6])), k1[7] * clamp_exp(rr - (pre1 + l1[7])));
            const bf16x8 af0 = __builtin_bit_cast(bf16x8, a0), af1 = __builtin_bit_cast(bf16x8, a1);
            const float eRc = fast_exp(rr), dUc = fast_exp(bl - rr), dDc = fast_exp(bl);
            f32x4 er, du, dd;
#pragma unroll
            for (int j = 0; j < 4; ++j) { er[j] = __shfl(eRc, 4 * fq + j); du[j] = __shfl(dUc, 4 * fq + j); dd[j] = __shfl(dDc, 4 * fq + j); }
#pragma unroll
            for (int vt = 0; vt < 8; ++vt) {
                v4u b0, b1;
#define VSEL(r) ((vt & 1) ? ((vt >> 1) == 0 ? (r).x >> 16 : (vt >> 1) == 1 ? (r).y >> 16 : (vt >> 1) == 2 ? (r).z >> 16 : (r).w >> 16) \
                          : ((vt >> 1) == 0 ? (r).x & 0xffffu : (vt >> 1) == 1 ? (r).y & 0xffffu : (vt >> 1) == 2 ? (r).z & 0xffffu : (r).w & 0xffffu))
                b0.x = VSEL(vr0[0]) | (VSEL(vr0[1]) << 16); b0.y = VSEL(vr0[2]) | (VSEL(vr0[3]) << 16); b0.z = VSEL(vr0[4]) | (VSEL(vr0[5]) << 16); b0.w = VSEL(vr0[6]) | (VSEL(vr0[7]) << 16);
                b1.x = VSEL(vr1[0]) | (VSEL(vr1[1]) << 16); b1.y = VSEL(vr1[2]) | (VSEL(vr1[3]) << 16); b1.z = VSEL(vr1[4]) | (VSEL(vr1[5]) << 16); b1.w = VSEL(vr1[6]) | (VSEL(vr1[7]) << 16);
#undef VSEL
                f32x4 u = __builtin_amdgcn_mfma_f32_16x16x32_bf16(af0, __builtin_bit_cast(bf16x8, b0), (f32x4){0.f, 0.f, 0.f, 0.f}, 0, 0, 0);
                u = __builtin_amdgcn_mfma_f32_16x16x32_bf16(af1, __builtin_bit_cast(bf16x8, b1), u, 0, 0, 0);
                const f32x4 sp = S[vt] * er;
                v2u w; w.x = pk2(sp[0], sp[1]); w.y = pk2(sp[2], sp[3]);
                *(v2u*)(STi + (size_t)c * V * K + (size_t)vt * 16) = w;
                S[vt] = S[vt] * dd + u * du;
            }
        }
#pragma unroll
        for (int j = 0; j < 4; ++j) {
            float* o = A.s_out_prompt + ((size_t)(b * H + h) * K + 16 * ks + 4 * fq + j) * V + vq * 128 + 8 * fr;
            *(f32x4*)o = (f32x4){S[0][j], S[1][j], S[2][j], S[3][j]};
            *(f32x4*)(o + 4) = (f32x4){S[4][j], S[5][j], S[6][j], S[7][j]};
        }
    }
#if defined(EXP_SERIAL)
    __syncthreads();
    _Pragma("nounroll") for (int rep_t = 0; rep_t < REP_STREAM; ++rep_t)
    for (int n = wave;; n += NWAVES) {
        const int it = F.vcu + F.G * n;
        if (it >= NST) break;
#elif defined(EXP_SERIAL4)
    __syncthreads();
    for (int n = wave - 4; n >= 0; n += 4) {
        const int it = F.vcu + F.G * n;
        if (it >= NST) break;
#elif defined(EXP_STATIC)
    constexpr int NSW = NSI / 256;
    for (int n = wave - NSW; n >= 0; n += NWAVES - NSW) {
        const int it = F.vcu + F.G * n;
        if (it >= NST) break;
#else
    for (;;) {
        unsigned n = 0;
        if (lane == 0) n = __hip_atomic_fetch_add(cnt, 1u, __ATOMIC_RELAXED, __HIP_MEMORY_SCOPE_WORKGROUP);
        n = (unsigned)__builtin_amdgcn_readfirstlane((int)n);
        const int it = F.vcu + F.G * (int)n;
        if (it >= NST) break;
#endif
        const int vp = it % VP, h = (it / VP) % H, b = it / (VP * H), R0 = MP + b * TS;
        float a[10];
#pragma unroll
        for (int i = 0; i < 10; ++i) a[i] = 0.f;
#pragma unroll
        for (int m = 0; m < KPL; ++m) {
            const int kk = lane + 64 * m, col = h * K + kk;
            float bt[4], q[4], kx[4];
#pragma unroll
            for (int t = 0; t < 4; ++t) { bt[t] = A.LF[(size_t)(R0 + t) * LDLF + col]; q[t] = bf2f(A.QB[(size_t)(R0 + t) * LDQK + col]); kx[t] = bf2f(A.KB[(size_t)(R0 + t) * LDQK + col]); }
#pragma unroll
            for (int t = 1; t < 4; ++t) bt[t] += bt[t - 1];
            LAS float* vk = vec + kk * 12;
            vk[0] = fast_exp(bt[3]);
#pragma unroll
            for (int t = 0; t < 4; ++t) { vk[1 + t] = kx[t] * fast_exp(bt[3] - bt[t]); vk[5 + t] = q[t] * fast_exp(bt[t]); }
#pragma unroll
            for (int t = 0; t < 4; ++t)
#pragma unroll
                for (int s = 0; s <= t; ++s) a[t * (t + 1) / 2 + s] += q[t] * kx[s] * fast_exp(bt[t] - bt[s]);
        }
#pragma unroll
        for (int i = 0; i < 10; ++i) a[i] = wave_sum(a[i]);
        const int vc = h * V + vp * VWS + CPL * lane;
        float vs[4][CPL], o[4][CPL];
#pragma unroll
        for (int s = 0; s < 4; ++s) {
            if constexpr (CPL == 4) { const v2u raw = *(const v2u*)(A.VB + (size_t)(R0 + s) * D + vc); vs[s][0] = bflo(raw.x); vs[s][1] = bfhi(raw.x); vs[s][2] = bflo(raw.y); vs[s][3] = bfhi(raw.y); }
            else { const unsigned raw = *(const unsigned*)(A.VB + (size_t)(R0 + s) * D + vc); vs[s][0] = bflo(raw); vs[s][1] = bfhi(raw); }
#pragma unroll
            for (int e = 0; e < CPL; ++e) o[s][e] = 0.f;
        }
        LDS_WAIT(); asm volatile("" ::: "memory");
        typedef float fcpl __attribute__((ext_vector_type(CPL)));
        const float* sin = A.s_in + (size_t)(b * H + h) * K * V + vp * VWS + CPL * lane;
        float* sout = A.s_out_sample + (size_t)(b * H + h) * K * V + vp * VWS + CPL * lane;
        for (int kr = 0; kr < K; kr += 8) {
            fcpl sv[8];
#pragma unroll
            for (int u = 0; u < 8; ++u) sv[u] = *(const fcpl*)(sin + (size_t)(kr + u) * V);
#pragma unroll
            for (int u = 0; u < 8; ++u) {
                const LAS f32x4* vk = (const LAS f32x4*)(vec + (kr + u) * 12);
                const f32x4 c0 = vk[0], c1 = vk[1], c2 = vk[2];
                fcpl sn;
#pragma unroll
                for (int e = 0; e < CPL; ++e) {
                    const float s0 = sv[u][e];
                    sn[e] = c0[0] * s0 + c0[1] * vs[0][e] + c0[2] * vs[1][e] + c0[3] * vs[2][e] + c1[0] * vs[3][e];
                    o[0][e] += c1[1] * s0; o[1][e] += c1[2] * s0; o[2][e] += c1[3] * s0; o[3][e] += c2[0] * s0;
                }
                *(fcpl*)(sout + (size_t)(kr + u) * V) = sn;
            }
        }
#pragma unroll
        for (int t = 0; t < 4; ++t) {
            fcpl ov;
#pragma unroll
            for (int e = 0; e < CPL; ++e) { float x = o[t][e];
#pragma unroll
                for (int s = 0; s <= t; ++s) x += a[t * (t + 1) / 2 + s] * vs[s][e];
                ov[e] = x; }
            *(fcpl*)(A.ORAW + (size_t)(R0 - MP + t) * D + vc) = ov;
        }
        asm volatile("" ::: "memory");
    }
}

template <bool GLA> __device__ __forceinline__ void rec_pass_b(Frame& F, const RecArgs& A) {
    typedef RecCfg<GLA> C; constexpr int K = C::K, V = C::V, H = C::H, SSEG = C::SSEG, L = C::L, KP = C::KP, SP = C::SP, VTW = (V / 16) / 8, KS = K / 32;
    LAS bf16* Qh = (LAS bf16*)F.lds;
    LAS bf16* Kh = Qh + CH * KP;
    LAS bf16* P = Kh + CH * KP;
    LAS bf16* Vt = P + CH * SP;
    LAS float* segtot = (LAS float*)(Vt + V * SP);
    LAS float* part = segtot + SSEG * K;
    const int tid = F.tid, lane = F.lane, wave = F.wave, fr = lane & 15, fq = lane >> 4;
    const int k = tid % K, sg = tid / K;
    for (int r = F.vcu * NWAVES + wave; r < MS; r += F.G * NWAVES) {
        f32x4 v[8]; row_load(A.ORAW + (size_t)r * D, lane, v);
        float rs[8];
#pragma unroll
        for (int j = 0; j < 8; ++j) rs[j] = (v[j][0] * v[j][0] + v[j][1] * v[j][1]) + (v[j][2] * v[j][2] + v[j][3] * v[j][3]);
        if constexpr (GLA) {
#pragma unroll
            for (int p = 0; p < 4; ++p) { const float t = wave_sum(rs[2 * p] + rs[2 * p + 1]); rs[2 * p] = t; rs[2 * p + 1] = t; }
        } else {
#pragma unroll
            for (int j = 0; j < 8; ++j) { float t = rs[j];
#pragma unroll
                for (int o = 1; o < 32; o <<= 1) t += __shfl_xor(t, o);
                rs[j] = t; }
        }
        const bf16* grow = A.GB + (size_t)(MP + r) * D; GAS v2u* o8 = (GAS v2u*)(A.O + (size_t)(MP + r) * D) + lane;
#pragma unroll
        for (int j = 0; j < 8; ++j) {
            const float rstd = 1.0f / sqrtf(rs[j] * (1.0f / V) + LN_EPS);
            const f32x4 nw = *((const GAS f32x4*)A.normw + lane + 64 * j);
            const v2u graw = *((const GAS v2u*)grow + lane + 64 * j);
            const f32x4 gt = (f32x4){bflo(graw.x), bfhi(graw.x), bflo(graw.y), bfhi(graw.y)};
            const f32x4 x = v[j] * rstd * nw * gt;
            v2u w; w.x = pk2(x[0], x[1]); w.y = pk2(x[2], x[3]); o8[64 * j] = w;
        }
    }
    for (int it = F.vcu; it < NBP * NCH * H; it += F.G) {
        const int h = it % H, c = (it / H) % NCH, b = it / (H * NCH), R0 = b * SEQ + c * CH;
#pragma unroll
        for (int i = 0; i < V / 64; ++i) {
            const int s = tid & 63, v0 = (wave + 8 * i) * 8;
            const v4u raw = *(const v4u*)(A.VB + (size_t)(R0 + s) * D + h * V + v0);
            Vt[(v0 + 0) * SP + s] = (bf16)(raw.x & 0xffffu); Vt[(v0 + 1) * SP + s] = (bf16)(raw.x >> 16);
            Vt[(v0 + 2) * SP + s] = (bf16)(raw.y & 0xffffu); Vt[(v0 + 3) * SP + s] = (bf16)(raw.y >> 16);
            Vt[(v0 + 4) * SP + s] = (bf16)(raw.z & 0xffffu); Vt[(v0 + 5) * SP + s] = (bf16)(raw.z >> 16);
            Vt[(v0 + 6) * SP + s] = (bf16)(raw.w & 0xffffu); Vt[(v0 + 7) * SP + s] = (bf16)(raw.w >> 16);
        }
        {
            float lf[L];
#pragma unroll
            for (int i = 0; i < L; ++i) lf[i] = A.LF[(size_t)(R0 + sg * L + i) * C::LDLF + h * K + k];
#pragma unroll
            for (int i = 1; i < L; ++i) lf[i] += lf[i - 1];
            segtot[sg * K + k] = lf[L - 1];
            __syncthreads();
            float pre = 0.f, rr = 0.f;
#pragma unroll
            for (int s2 = 0; s2 < SSEG; ++s2) { const float t = segtot[s2 * K + k]; if (s2 < sg) pre += t; if (s2 < SSEG / 2) rr += t; }
#pragma unroll
            for (int i = 0; i < L; ++i) {
                const int s = sg * L + i;
                const float bb = pre + lf[i];
                const float qv = bf2f(A.QB[(size_t)(R0 + s) * C::LDQK + h * K + k]), kv = bf2f(A.KB[(size_t)(R0 + s) * C::LDQK + h * K + k]);
                Qh[s * KP + k] = (bf16)f2bf(qv * clamp_exp(bb - rr));
                Kh[s * KP + k] = (bf16)f2bf(kv * clamp_exp(rr - bb));
            }
        }
        __syncthreads();
#pragma unroll
        for (int i = 0; i < 2; ++i) {
            const int tile = wave * 2 + i, st = tile >> 2, tt = tile & 3;
            f32x4 a4 = (f32x4){0.f, 0.f, 0.f, 0.f};
            if (st <= tt) {
#pragma unroll
                for (int ks = 0; ks < KS; ++ks) {
                    const bf16x8 a = *(const LAS bf16x8*)(Kh + (16 * st + fr) * KP + 32 * ks + 8 * fq);
                    const bf16x8 bq = *(const LAS bf16x8*)(Qh + (16 * tt + fr) * KP + 32 * ks + 8 * fq);
                    a4 = __builtin_amdgcn_mfma_f32_16x16x32_bf16(a, bq, a4, 0, 0, 0);
                }
                const int t = 16 * tt + fr;
#pragma unroll
                for (int j = 0; j < 4; ++j) if (16 * st + 4 * fq + j > t) a4[j] = 0.f;
            }
            v2u w; w.x = pk2(a4[0], a4[1]); w.y = pk2(a4[2], a4[3]);
            *(LAS v2u*)(P + (16 * tt + fr) * SP + 16 * st + 4 * fq) = w;
        }
        __syncthreads();
        const bf16* STi = A.ST + (size_t)((b * H + h) * NCH + c) * V * K;
        f32x4 acc[VTW][4];
        float ssq[4] = {0.f, 0.f, 0.f, 0.f};
#pragma unroll
        for (int iv = 0; iv < VTW; ++iv) {
            const int vt = wave * VTW + iv;
#pragma unroll
            for (int tt = 0; tt < 4; ++tt) acc[iv][tt] = (f32x4){0.f, 0.f, 0.f, 0.f};
#pragma unroll
            for (int ks = 0; ks < 2; ++ks) {
                const bf16x8 a = *(const LAS bf16x8*)(Vt + (16 * vt + fr) * SP + 32 * ks + 8 * fq);
#pragma unroll
                for (int tt = 0; tt < 4; ++tt) {
                    const bf16x8 bp = *(const LAS bf16x8*)(P + (16 * tt + fr) * SP + 32 * ks + 8 * fq);
                    acc[iv][tt] = __builtin_amdgcn_mfma_f32_16x16x32_bf16(a, bp, acc[iv][tt], 0, 0, 0);
                }
            }
#pragma unroll
            for (int ks = 0; ks < KS; ++ks) {
                const bf16x8 a = *(const bf16x8*)(STi + ((size_t)(2 * ks + (fq >> 1)) * V + 16 * vt + fr) * 16 + 8 * (fq & 1));
#pragma unroll
                for (int tt = 0; tt < 4; ++tt) {
                    const bf16x8 bq = *(const LAS bf16x8*)(Qh + (16 * tt + fr) * KP + 32 * ks + 8 * fq);
                    acc[iv][tt] = __builtin_amdgcn_mfma_f32_16x16x32_bf16(a, bq, acc[iv][tt], 0, 0, 0);
                }
            }
#pragma unroll
            for (int tt = 0; tt < 4; ++tt) { const f32x4 x = acc[iv][tt]; ssq[tt] += (x[0] * x[0] + x[1] * x[1]) + (x[2] * x[2] + x[3] * x[3]); }
            asm volatile("" ::: "memory");
        }
#pragma unroll
        for (int tt = 0; tt < 4; ++tt) { float s = ssq[tt]; s += __shfl_xor(s, 16); s += __shfl_xor(s, 32); if (fq == 0) part[wave * 64 + 16 * tt + fr] = s; }
        __syncthreads();
#pragma unroll
        for (int tt = 0; tt < 4; ++tt) {
            const int t = 16 * tt + fr; float tot = 0.f;
#pragma unroll
            for (int w = 0; w < 8; ++w) tot += part[w * 64 + t];
            const float rstd = 1.0f / sqrtf(tot * (1.0f / V) + LN_EPS);
#pragma unroll
            for (int iv = 0; iv < VTW; ++iv) {
                const int v0 = 16 * (wave * VTW + iv) + 4 * fq;
                const f32x4 nw = *(const f32x4*)(A.normw + h * V + v0);
                const v2u graw = *(const v2u*)(A.GB + (size_t)(R0 + t) * D + h * V + v0);
                const f32x4 gt = (f32x4){bflo(graw.x), bfhi(graw.x), bflo(graw.y), bfhi(graw.y)};
                const f32x4 r = acc[iv][tt] * rstd * nw * gt;
                v2u w; w.x = pk2(r[0], r[1]); w.y = pk2(r[2], r[3]);
                *(v2u*)(A.O + (size_t)(R0 + t) * D + h * V + v0) = w;
            }
        }
        __syncthreads();
    }
}

constexpr int NPHASE = 3 + 8 * DEPTH;
#ifndef REP_G
#define REP_G 1
#endif
#ifndef REP_R
#define REP_R 1
#endif
#ifndef REP_L
#define REP_L 1
#endif
#ifndef REP_P
#define REP_P 1
#endif
#define REPEAT(n) _Pragma("nounroll") for (int rep_ = 0; rep_ < (n); ++rep_)
__device__ __forceinline__ RecArgs rec_args_hg(const Frame& F, int j) {
    RecArgs ra;
    ra.QB = (const bf16*)(F.ws + WS_QB); ra.KB = (const bf16*)(F.ws + WS_KB); ra.VB = (const bf16*)(F.ws + WS_VB); ra.GB = (const bf16*)(F.ws + WS_GB); ra.LF = (const float*)(F.ws + WS_LF);
    ra.O = (bf16*)(F.ws + WS_O); ra.ST = (bf16*)(F.ws + WS_ST); ra.ORAW = (float*)(F.ws + WS_ORAW);
    ra.normw = F.ka->in[12] + (size_t)j * D;
    ra.s_in = F.ka->in[2] + (size_t)j * NBS * HG_H * HG_K * HG_V; ra.s_out_sample = F.out + O_HGS + (size_t)j * NBS * HG_H * HG_K * HG_V; ra.s_out_prompt = F.out + O_HGP + (size_t)j * NBP * HG_H * HG_K * HG_V;
    return ra;
}
__device__ __forceinline__ RecArgs rec_args_gla(const Frame& F, int j) {
    RecArgs ra;
    ra.QB = (const bf16*)(F.ws + WS_QB); ra.KB = (const bf16*)(F.ws + WS_KB); ra.VB = (const bf16*)(F.ws + WS_VB); ra.GB = (const bf16*)(F.ws + WS_GB); ra.LF = (const float*)(F.ws + WS_LF);
    ra.O = (bf16*)(F.ws + WS_O); ra.ST = (bf16*)(F.ws + WS_ST); ra.ORAW = (float*)(F.ws + WS_ORAW);
    ra.normw = F.ka->in[17] + (size_t)j * D;
    ra.s_in = F.ka->in[3] + (size_t)j * NBS * GL_H * GL_K * GL_V; ra.s_out_sample = F.out + O_GLS + (size_t)j * NBS * GL_H * GL_K * GL_V; ra.s_out_prompt = F.out + O_GLP + (size_t)j * NBP * GL_H * GL_K * GL_V;
    return ra;
}
__global__ void __launch_bounds__(NT, 2) fwd_kernel(Args args) {
    const int lo = args.ph_lo, hi = args.ph_hi;
    {
        Frame F = mk_frame();
        if (F.tid < 32) F.MISC[F.tid] = 0u;
        __syncthreads();
        if (!MK_PER_PHASE) (void)xcd_barrier_post((unsigned*)F.ws + CW_BAR, F.MISC);
    }
#define IN(k) (lo <= (k) && (k) < hi)
#define SEAM(k) do { if (IN(k) && IN((k) + 1)) { Frame Fb = mk_frame(); XcdBarrier bar; bar.bar = (unsigned*)Fb.ws + CW_BAR; bar.x = xb_xcc_id(); bar.st = Fb.MISC; xcd_barrier(bar); } } while (0)

    if (IN(0)) REPEAT(REP_P) { Frame F = mk_frame(); phase_p0(F); } SEAM(0);
    if (IN(1)) REPEAT(REP_P) { Frame F = mk_frame(); phase_p1(F); } SEAM(1);
    if (IN(2)) REPEAT(REP_P) { Frame F = mk_frame(); phase_p2(F); } SEAM(2);

#pragma nounroll
    for (int l = 0; l < DEPTH; ++l) {
        const int p0 = 3 + 8 * l, j = l >> 1;
        if ((l & 1) == 0) {
            if (IN(p0)) REPEAT(REP_G) {
                Frame F = mk_frame();
                pg8::GemmX g{(const bf16*)(F.ws + WS_H), (const bf16*)(F.ws + WS_H) + (size_t)MP * D, (const bf16*)(F.ws + WS_HGWI) + (size_t)j * 8192 * D, 8192, D}; pg8::StaticOrder S; S.init(MP, 8192, F.G, F.bx);
                EpiHgIn E{(bf16*)(F.ws + WS_QB), (float*)(F.ws + WS_LF), (const float*)(F.ws + WS_LB) + j * D};
                pg8::gemm_phase_x<EpiHgIn, pg8::StaticOrder>(F.lds, g, S, E);
            }
            SEAM(p0);
            if (IN(p0 + 1)) REPEAT(REP_R) { Frame F = mk_frame(); const RecArgs ra = rec_args_hg(F, j); rec_pass_a<false>(F, ra); }
            SEAM(p0 + 1);
            if (IN(p0 + 2)) REPEAT(REP_R) { Frame F = mk_frame(); const RecArgs ra = rec_args_hg(F, j); rec_pass_b<false>(F, ra); }
            SEAM(p0 + 2);
            if (IN(p0 + 3)) REPEAT(REP_G) {
                Frame F = mk_frame();
                pg8::GemmX g{(const bf16*)(F.ws + WS_O), (const bf16*)(F.ws + WS_O) + (size_t)MP * D, (const bf16*)(F.ws + WS_HGWO) + (size_t)j * D * D, D, D}; pg8::StaticOrder S; S.init(MP, D, F.G, F.bx);
                EpiRes E{(const float*)(F.ws + WS_X), (float*)(F.ws + WS_Z), (const float*)(F.ws + WS_MOD) + (size_t)(l * 6 + 2) * D};
                pg8::gemm_phase_x<EpiRes, pg8::StaticOrder>(F.lds, g, S, E);
            }
            SEAM(p0 + 3);
        } else {
            if (IN(p0)) REPEAT(REP_G) {
                Frame F = mk_frame();
                pg8::GemmX g{(const bf16*)(F.ws + WS_H), (const bf16*)(F.ws + WS_H) + (size_t)MP * D, (const bf16*)(F.ws + WS_GLWI) + (size_t)j * GL_INP * D, GL_INP, D}; pg8::StaticOrder S; S.init(MP, GL_INP, F.G, F.bx);
                EpiGlaIn E{(bf16*)(F.ws + WS_QB)};
                pg8::gemm_phase_x<EpiGlaIn, pg8::StaticOrder>(F.lds, g, S, E);
            }
            SEAM(p0);
            if (IN(p0 + 1)) REPEAT(REP_R) { Frame F = mk_frame(); const RecArgs ra = rec_args_gla(F, j); rec_pass_a<true>(F, ra); }
            SEAM(p0 + 1);
            if (IN(p0 + 2)) REPEAT(REP_R) { Frame F = mk_frame(); const RecArgs ra = rec_args_gla(F, j); rec_pass_b<true>(F, ra); }
            SEAM(p0 + 2);
            if (IN(p0 + 3)) REPEAT(REP_G) {
                Frame F = mk_frame();
                pg8::GemmX g{(const bf16*)(F.ws + WS_O), (const bf16*)(F.ws + WS_O) + (size_t)MP * D, (const bf16*)(F.ws + WS_GLWO) + (size_t)j * D * D, D, D}; pg8::StaticOrder S; S.init(MP, D, F.G, F.bx);
                EpiRes E{(const float*)(F.ws + WS_X), (float*)(F.ws + WS_Z), (const float*)(F.ws + WS_MOD) + (size_t)(l * 6 + 2) * D};
                pg8::gemm_phase_x<EpiRes, pg8::StaticOrder>(F.lds, g, S, E);
            }
            SEAM(p0 + 3);
        }
        if (IN(p0 + 4)) REPEAT(REP_L) { Frame F = mk_frame(); phase_ln<false>(F, F.ka->in[8] + (size_t)(l * 2 + 0) * D, F.ka->in[9] + (size_t)(l * 2 + 0) * D, (l * 6 + 4) * D, (l * 6 + 3) * D, false, 0); }
        SEAM(p0 + 4);
        if (IN(p0 + 5)) REPEAT(REP_G) {
            Frame F = mk_frame();
            pg8::GemmX g{(const bf16*)(F.ws + WS_H), (const bf16*)(F.ws + WS_H) + (size_t)MP * D, (const bf16*)(F.ws + WS_WUP) + (size_t)l * DFF * D, DFF, D}; pg8::StaticOrder S; S.init(MP, DFF, F.G, F.bx);
            EpiUp E{(bf16*)(F.ws + WS_U)};
            pg8::gemm_phase_x<EpiUp, pg8::StaticOrder>(F.lds, g, S, E);
        }
        SEAM(p0 + 5);
        if (IN(p0 + 6)) REPEAT(REP_G) {
            Frame F = mk_frame();
            pg8::GemmX g{(const bf16*)(F.ws + WS_U), (const bf16*)(F.ws + WS_U) + (size_t)MP * DFF, (const bf16*)(F.ws + WS_WDN) + (size_t)l * D * DFF, D, DFF}; pg8::StaticOrder S; S.init(MP, D, F.G, F.bx);
            EpiRes E{(const float*)(F.ws + WS_X), (float*)(F.ws + WS_Z), (const float*)(F.ws + WS_MOD) + (size_t)(l * 6 + 5) * D};
            pg8::gemm_phase_x<EpiRes, pg8::StaticOrder>(F.lds, g, S, E);
        }
        SEAM(p0 + 6);
        if (IN(p0 + 7)) REPEAT(REP_L) { Frame F = mk_frame();
            if ((l & 1) == 0) phase_ln<true>(F, F.ka->in[8] + (size_t)(l * 2 + 1) * D, F.ka->in[9] + (size_t)(l * 2 + 1) * D, ((l + 1) * 6 + 1) * D, ((l + 1) * 6 + 0) * D, false, j);
            else phase_ln<false>(F, F.ka->in[8] + (size_t)(l * 2 + 1) * D, F.ka->in[9] + (size_t)(l * 2 + 1) * D, ((l + 1) * 6 + 1) * D, ((l + 1) * 6 + 0) * D, l == DEPTH - 1, 0); }
        if (l + 1 < DEPTH) SEAM(p0 + 7);
    }
#undef IN
#undef SEAM
}

extern "C" void kernel_launch(void* const* d_in, const int* in_sizes, int n_in, void* d_out, int out_size, void* d_ws, size_t ws_size, hipStream_t stream) {
    static int grid = 0;
    if (grid == 0) {
        if (n_in != 21 || (size_t)out_size != O_END || ws_size < WS_END) { fprintf(stderr, "kernel_launch: unexpected problem (n_in %d, out %d, ws %zu; need out %zu, ws >= %zu); nothing launched\n", n_in, out_size, ws_size, (size_t)O_END, (size_t)WS_END); grid = -1; return; }
        int dev = 0, cus = 0, per_cu = 0;
        if (hipGetDevice(&dev) != hipSuccess || hipDeviceGetAttribute(&cus, hipDeviceAttributeMultiprocessorCount, dev) != hipSuccess) { grid = -1; return; }
        if (hipFuncSetAttribute((const void*)fwd_kernel, hipFuncAttributeMaxDynamicSharedMemorySize, LDS_BYTES) != hipSuccess) { fprintf(stderr, "kernel_launch: hipFuncSetAttribute failed\n"); grid = -1; return; }
        if (hipOccupancyMaxActiveBlocksPerMultiprocessor(&per_cu, (const void*)fwd_kernel, NT, LDS_BYTES) != hipSuccess || per_cu < 1) fprintf(stderr, "kernel_launch: occupancy query says %d\n", per_cu);
        (void)hipGetLastError();
        grid = cus;
    }
    if (grid < 0) return;
    if (hipMemsetAsync((char*)d_ws + WS_CTL, 0, CTL_ZERO_BYTES, stream) != hipSuccess) return;
    Args a{};
    for (int i = 0; i < 21; ++i) a.in[i] = (const float*)d_in[i];
    a.out = (float*)d_out; a.ws = (unsigned char*)d_ws;
#if MK_PER_PHASE
    for (int p = 0; p < NPHASE; ++p) { a.ph_lo = p; a.ph_hi = p + 1; hipLaunchKernelGGL(fwd_kernel, dim3(grid), dim3(NT), LDS_BYTES, stream, a); }
#else
    a.ph_lo = 0; a.ph_hi = NPHASE;
    hipLaunchKernelGGL(fwd_kernel, dim3(grid), dim3(NT), LDS_BYTES, stream, a);
#endif
    const hipError_t le = hipPeekAtLastError();
    if (le != hipSuccess) fprintf(stderr, "kernel_launch: launch failed: %s\n", hipGetErrorName(le));
}
```

```cpp
#define EXP_SERIAL 1
#include <hip/hip_runtime.h>
#include <cstdio>
#include <cstdint>
namespace pg8 {
#define PG8_LAS __attribute__((address_space(3)))
typedef unsigned short bf16_t;
typedef short bf16x8 __attribute__((ext_vector_type(8)));
typedef float f32x4 __attribute__((ext_vector_type(4)));
typedef unsigned u32x4 __attribute__((ext_vector_type(4)));
constexpr int BM = 256, BK = 64, HALF = 128, HTB = HALF * BK * 2  , STAGE_BYTES = 8 * HTB, NXCD = 8, WGM = 8;

__host__ __device__ __forceinline__ int lds_byte(int r, int c) { const int st = (r >> 4) * 2 + (c >> 5), rr = r & 15, cc = c & 31, ob = rr * 64 + cc * 2; return st * 1024 + (ob ^ (((ob >> 9) & 1) << 5)); }
__host__ __device__ __forceinline__ void stage_rc(int b, int& R, int& C) { const int st = b / 1024, sb = b % 1024, swz = sb ^ (((sb >> 9) & 1) << 5); R = (st >> 1) * 16 + swz / 64; C = (st & 1) * 32 + (swz % 64) / 2; }
__host__ __device__ __forceinline__ int perm32(int rho) { const int n = rho >> 4, i = rho & 15; return 8 * (i >> 2) + 4 * n + (i & 3); }

struct Unit { int pm, pn; };
struct Gemm { const bf16_t* A; const bf16_t* Bt; int M, N, K; };

struct StaticOrder {
    int nM, nN, nwg, G, c;
    __host__ __device__ void init(int M, int N, int G_, int c_) { nM = M / BM; nN = N / BM; nwg = nM * nN; G = G_; c = c_; }
    __host__ __device__ bool next(int i, Unit& u) const {
        const long L = (long)i * G + c; if (L >= nwg) return false;
        int wgid = (int)L; { const int q = nwg / NXCD, r = nwg % NXCD, xcd = wgid % NXCD, off = wgid / NXCD; wgid = (xcd < r ? xcd * (q + 1) : r * (q + 1) + (xcd - r) * q) + off; }
        const int nig = WGM * nN, gid = wgid / nig, fm = gid * WGM, gsz = (nM - fm) < WGM ? (nM - fm) : WGM;
        u.pm = fm + ((wgid % nig) % gsz); u.pn = (wgid % nig) / gsz; return true;
    }
    __device__ __forceinline__ void a_ready(const Unit&) const {}
    __device__ __forceinline__ void done(const Unit&) const {}
};

__device__ __forceinline__ unsigned cvt_pk_bf16(float lo, float hi) { unsigned r; asm volatile("v_cvt_pk_bf16_f32 %0, %1, %2" : "=v"(r) : "v"(lo), "v"(hi)); return r; }
template <class Epi, class Sched, bool ALIGN_EPI = false, bool SP2 = false>
__device__ __forceinline__ void gemm_phase(PG8_LAS unsigned char* lds, const Gemm g, const Sched& S, const Epi& E) {
    int tid_ = threadIdx.x; asm volatile("" : "+v"(tid_));
    const int tid = tid_, wid = __builtin_amdgcn_readfirstlane(tid >> 6), lane = tid & 63, wr = wid >> 2, wc = wid & 3, fr = lane & 15, fq = lane >> 4;
    const int K = g.K, nt = K / BK;
    unsigned voffA[2], voffB[2];
#pragma unroll
    for (int i = 0; i < 2; ++i) { int R, C; stage_rc(tid * 16 + i * 8192, R, C); const int Rb = Epi::PERM ? ((R & ~31) + perm32(R & 31)) : R;
        voffA[i] = (unsigned)(R * K + C) * 2u; voffB[i] = (unsigned)(Rb * K + C) * 2u; }
    const size_t kstep = (size_t)(BK * 2);
    const size_t hstep = (size_t)HALF * K * 2;
    const size_t tstep = 2 * hstep;
    const unsigned ldsw = (unsigned)wid * 1024u;
    const int aoff = lds_byte(wr * 64 + fr, fq * 8), boff = lds_byte(wc * 32 + fr, fq * 8);
#define PG8_SA(b, h) (((b) * 2 + (h)) * HTB)
#define PG8_SB(b, h) ((4 + (b) * 2 + (h)) * HTB)
#define PG8_STAGE(bufoff, gbase, voff) do { _Pragma("unroll") for (int _i = 0; _i < 2; ++_i) \
        __builtin_amdgcn_global_load_lds((const unsigned*)((const char*)(gbase) + (voff)[_i]), (PG8_LAS unsigned*)(lds + (bufoff) + ldsw + _i * 8192), 16, 0, 0); } while (0)
#define PG8_LDA(dst, b, h) do { _Pragma("unroll") for (int m = 0; m < 4; ++m) _Pragma("unroll") for (int k = 0; k < 2; ++k) dst[m][k] = *(const PG8_LAS bf16x8*)(lds + PG8_SA(b, h) + aoff + m * 2048 + k * 1024); } while (0)
#define PG8_LDB(dst, b, h) do { _Pragma("unroll") for (int n = 0; n < 2; ++n) _Pragma("unroll") for (int k = 0; k < 2; ++k) dst[n][k] = *(const PG8_LAS bf16x8*)(lds + PG8_SB(b, h) + boff + n * 2048 + k * 1024); } while (0)
#define PG8_MMA(ai, bj, At, Bt) do { __builtin_amdgcn_s_setprio(1); _Pragma("unroll") for (int m = 0; m < 4; ++m) _Pragma("unroll") for (int n = 0; n < 2; ++n) _Pragma("unroll") for (int k = 0; k < 2; ++k) \
        acc[ai][bj][m][n] = __builtin_amdgcn_mfma_f32_16x16x32_bf16(Bt[n][k], At[m][k], acc[ai][bj][m][n], 0, 0, 0); __builtin_amdgcn_s_setprio(0); } while (0)
#define PG8_WAIT_V(n) asm volatile("s_waitcnt vmcnt(" #n ")" ::: "memory")
#define PG8_WAIT_L(n) asm volatile("s_waitcnt lgkmcnt(" #n ")" ::: "memory")
#define PG8_BAR __builtin_amdgcn_s_barrier()
#define PG8_SCHED __builtin_amdgcn_sched_barrier(0)
    Unit cur, nxt; int ui = 0;
    if (!S.next(0, cur)) return;
    f32x4 acc[2][2][4][2];
#pragma unroll
    for (int a = 0; a < 2; ++a)
#pragma unroll
        for (int b = 0; b < 2; ++b)
#pragma unroll
            for (int m = 0; m < 4; ++m)
#pragma unroll
                for (int n = 0; n < 2; ++n) acc[a][b][m][n] = (f32x4){0.f, 0.f, 0.f, 0.f};
    bf16x8 At[4][2], B0[2][2], B1[2][2];
    const char* cA = (const char*)g.A + (size_t)cur.pm * tstep; const char* cB = (const char*)g.Bt + (size_t)cur.pn * tstep;
    S.a_ready(cur);
    if constexpr (SP2) {
        PG8_STAGE(PG8_SB(0, 0), cB, voffB); PG8_STAGE(PG8_SB(0, 1), cB + hstep, voffB); PG8_STAGE(PG8_SA(0, 0), cA, voffA); PG8_STAGE(PG8_SA(0, 1), cA + hstep, voffA);
        if (wr == 1) PG8_BAR;
        PG8_WAIT_V(2); PG8_BAR;
        PG8_STAGE(PG8_SB(1, 0), cB + kstep, voffB); PG8_STAGE(PG8_SA(1, 0), cA + kstep, voffA); PG8_STAGE(PG8_SB(1, 1), cB + hstep + kstep, voffB);
        PG8_WAIT_V(6); PG8_BAR;
    } else {
        PG8_STAGE(PG8_SB(0, 0), cB, voffB); PG8_STAGE(PG8_SA(0, 0), cA, voffA); PG8_STAGE(PG8_SB(0, 1), cB + hstep, voffB); PG8_STAGE(PG8_SA(0, 1), cA + hstep, voffA);
        if (wr == 1) PG8_BAR;
        PG8_WAIT_V(4); PG8_BAR;
        PG8_STAGE(PG8_SB(1, 0), cB + kstep, voffB); PG8_STAGE(PG8_SA(1, 0), cA + kstep, voffA); PG8_STAGE(PG8_SB(1, 1), cB + hstep + kstep, voffB);
        PG8_WAIT_V(6); PG8_BAR;
    }
    for (;;) {
        const bool has_next = S.next(ui + 1, nxt);
        const char* nA = has_next ? (const char*)g.A + (size_t)nxt.pm * tstep : cA; const char* nB = has_next ? (const char*)g.Bt + (size_t)nxt.pn * tstep : cB;
        for (int t = 0; t < nt; t += 2) {
            const bool last = (t == nt - 2);
            const char* a1 = cA + (size_t)(t + 1) * kstep;
            const char* a2 = last ? nA : cA + (size_t)(t + 2) * kstep; const char* b2 = last ? nB : cB + (size_t)(t + 2) * kstep;
            const char* a3 = a2 + kstep; const char* b3 = b2 + kstep;
            if (last && has_next) S.a_ready(nxt);
            if constexpr (SP2) {
            PG8_LDB(B0, 0, 0); PG8_LDB(B1, 0, 1); PG8_SCHED; PG8_LDA(At, 0, 0); PG8_STAGE(PG8_SA(1, 1), a1 + hstep, voffA);
            PG8_WAIT_V(8); PG8_WAIT_L(0); PG8_BAR; PG8_MMA(0, 0, At, B0); PG8_MMA(0, 1, At, B1); PG8_BAR; PG8_SCHED;
            PG8_LDA(At, 0, 1); PG8_STAGE(PG8_SB(0, 0), b2, voffB); PG8_STAGE(PG8_SB(0, 1), b2 + hstep, voffB); PG8_STAGE(PG8_SA(0, 0), a2, voffA);
            PG8_WAIT_V(8); PG8_WAIT_L(0); PG8_BAR; PG8_MMA(1, 0, At, B0); PG8_MMA(1, 1, At, B1); PG8_BAR; PG8_SCHED;
            PG8_LDB(B0, 1, 0); PG8_LDB(B1, 1, 1); PG8_SCHED; PG8_LDA(At, 1, 0); PG8_STAGE(PG8_SA(0, 1), a2 + hstep, voffA);
            PG8_WAIT_V(8); PG8_WAIT_L(0); PG8_BAR; PG8_MMA(0, 0, At, B0); PG8_MMA(0, 1, At, B1); PG8_BAR; PG8_SCHED;
            PG8_LDA(At, 1, 1); PG8_STAGE(PG8_SB(1, 0), b3, voffB); PG8_STAGE(PG8_SB(1, 1), b3 + hstep, voffB); PG8_STAGE(PG8_SA(1, 0), a3, voffA);
            PG8_WAIT_V(8); PG8_WAIT_L(0); PG8_BAR; PG8_MMA(1, 0, At, B0); PG8_MMA(1, 1, At, B1); PG8_BAR; PG8_SCHED;
            } else {
            PG8_LDB(B0, 0, 0); PG8_SCHED; PG8_LDA(At, 0, 0); PG8_STAGE(PG8_SA(1, 1), a1 + hstep, voffA);
            PG8_WAIT_L(8); PG8_BAR; PG8_WAIT_L(0); PG8_MMA(0, 0, At, B0); PG8_BAR; PG8_SCHED;
            PG8_LDB(B1, 0, 1); PG8_STAGE(PG8_SB(0, 0), b2, voffB);
            PG8_BAR; PG8_WAIT_L(0); PG8_MMA(0, 1, At, B1); PG8_BAR;
            PG8_LDA(At, 0, 1); PG8_STAGE(PG8_SA(0, 0), a2, voffA);
            PG8_BAR; PG8_WAIT_L(0); PG8_MMA(1, 0, At, B0); PG8_BAR; PG8_SCHED;
            PG8_STAGE(PG8_SB(0, 1), b2 + hstep, voffB);
            PG8_WAIT_V(6); PG8_BAR; PG8_MMA(1, 1, At, B1); PG8_BAR;
            PG8_LDB(B0, 1, 0); PG8_SCHED; PG8_LDA(At, 1, 0); PG8_STAGE(PG8_SA(0, 1), a2 + hstep, voffA);
            PG8_WAIT_L(8); PG8_BAR; PG8_WAIT_L(0); PG8_MMA(0, 0, At, B0); PG8_BAR; PG8_SCHED;
            PG8_LDB(B1, 1, 1); PG8_STAGE(PG8_SB(1, 0), b3, voffB);
            PG8_BAR; PG8_WAIT_L(0); PG8_MMA(0, 1, At, B1); PG8_BAR;
            PG8_LDA(At, 1, 1); PG8_STAGE(PG8_SA(1, 0), a3, voffA);
            PG8_BAR; PG8_WAIT_L(0); PG8_MMA(1, 0, At, B0); PG8_BAR; PG8_SCHED;
            PG8_STAGE(PG8_SB(1, 1), b3 + hstep, voffB);
            PG8_WAIT_V(6); PG8_BAR; PG8_MMA(1, 1, At, B1); PG8_BAR;
            }
        }
        if constexpr (ALIGN_EPI) { if (wr == 0) PG8_BAR; }
        if constexpr (!Epi::AFTER_DRAIN) { E(acc, cur, wr, wc, fr, fq); S.done(cur); }
        if (!has_next) break;
#pragma unroll
        for (int a = 0; a < 2; ++a)
#pragma unroll
            for (int b = 0; b < 2; ++b)
#pragma unroll
                for (int m = 0; m < 4; ++m)
#pragma unroll
                    for (int n = 0; n < 2; ++n) acc[a][b][m][n] = (f32x4){0.f, 0.f, 0.f, 0.f};
        cur = nxt; cA = nA; cB = nB; ++ui;
        if constexpr (ALIGN_EPI) { if (wr == 1) PG8_BAR; }
    }
    PG8_WAIT_V(0);
    if constexpr (!ALIGN_EPI) { if (wr == 0) PG8_BAR; }
    PG8_BAR;
    if constexpr (Epi::AFTER_DRAIN) { E.fused(acc, cur, wr, wc, fr, fq, lds, wid, lane); S.done(cur); }
#undef PG8_SA
#undef PG8_SB
#undef PG8_STAGE
#undef PG8_LDA
#undef PG8_LDB
#undef PG8_MMA
#undef PG8_WAIT_V
#undef PG8_WAIT_L
#undef PG8_BAR
#undef PG8_SCHED
}

struct GemmX { const bf16_t* A; const bf16_t* AX; const bf16_t* Bt; int N, K; };
constexpr int XS_OFF = STAGE_BYTES, XS_BYTES = 2048, STAGE_BYTES_X = STAGE_BYTES + 2 * XS_BYTES;
template <class Epi, class Sched>
__device__ __forceinline__ void gemm_phase_x(PG8_LAS unsigned char* lds, const GemmX g, const Sched& S, const Epi& E) {
    int tid_ = threadIdx.x; asm volatile("" : "+v"(tid_));
    const int tid = tid_, wid = __builtin_amdgcn_readfirstlane(tid >> 6), lane = tid & 63, wr = wid >> 2, wc = wid & 3, fr = lane & 15, fq = lane >> 4;
    const int K = g.K, nt = K / BK;
    unsigned voffA[2], voffB[2], voffX;
#pragma unroll
    for (int i = 0; i < 2; ++i) { int R, C; stage_rc(tid * 16 + i * 8192, R, C); const int Rb = Epi::PERM ? ((R & ~31) + perm32(R & 31)) : R;
        voffA[i] = (unsigned)(R * K + C) * 2u; voffB[i] = (unsigned)(Rb * K + C) * 2u; }
    { int R, C; stage_rc(tid * 4, R, C); voffX = (unsigned)(R * K + C) * 2u; }
    const size_t kstep = (size_t)(BK * 2);
    const size_t hstep = (size_t)HALF * K * 2;
    const size_t tstep = 2 * hstep;
    const size_t xstep = (size_t)16 * K * 2;
    const unsigned ldsw = (unsigned)wid * 1024u, ldsx = (unsigned)wid * 256u;
    const int aoff = lds_byte(wr * 64 + fr, fq * 8), boff = lds_byte(wc * 32 + fr, fq * 8), xoff = lds_byte(fr, fq * 8);
#define PG8_SA(b, h) (((b) * 2 + (h)) * HTB)
#define PG8_SB(b, h) ((4 + (b) * 2 + (h)) * HTB)
#define PG8_SX(b) (XS_OFF + (b) * XS_BYTES)
#define PG8_STAGE(bufoff, gbase, voff) do { _Pragma("unroll") for (int _i = 0; _i < 2; ++_i) \
        __builtin_amdgcn_global_load_lds((const unsigned*)((const char*)(gbase) + (voff)[_i]), (PG8_LAS unsigned*)(lds + (bufoff) + ldsw + _i * 8192), 16, 0, 0); } while (0)
#define PG8_STAGEX(b, gbase) __builtin_amdgcn_global_load_lds((const unsigned*)((const char*)(gbase) + voffX), (PG8_LAS unsigned*)(lds + PG8_SX(b) + ldsx), 4, 0, 0)
#define PG8_LDA(dst, b, h) do { _Pragma("unroll") for (int m = 0; m < 4; ++m) _Pragma("unroll") for (int k = 0; k < 2; ++k) dst[m][k] = *(const PG8_LAS bf16x8*)(lds + PG8_SA(b, h) + aoff + m * 2048 + k * 1024); } while (0)
#define PG8_LDB(dst, b, h) do { _Pragma("unroll") for (int n = 0; n < 2; ++n) _Pragma("unroll") for (int k = 0; k < 2; ++k) dst[n][k] = *(const PG8_LAS bf16x8*)(lds + PG8_SB(b, h) + boff + n * 2048 + k * 1024); } while (0)
#define PG8_LDX(b) do { _Pragma("unroll") for (int k = 0; k < 2; ++k) Ax[k] = *(const PG8_LAS bf16x8*)(lds + PG8_SX(b) + xoff + k * 1024); } while (0)
#define PG8_MMA(ai, bj, At, Bt) do { __builtin_amdgcn_s_setprio(1); _Pragma("unroll") for (int m = 0; m < 4; ++m) _Pragma("unroll") for (int n = 0; n < 2; ++n) _Pragma("unroll") for (int k = 0; k < 2; ++k) \
        acc[ai][bj][m][n] = __builtin_amdgcn_mfma_f32_16x16x32_bf16(Bt[n][k], At[m][k], acc[ai][bj][m][n], 0, 0, 0); __builtin_amdgcn_s_setprio(0); } while (0)
#define PG8_MMAX() do { __builtin_amdgcn_s_setprio(1); if (wr == 0) { _Pragma("unroll") for (int n = 0; n < 2; ++n) _Pragma("unroll") for (int k = 0; k < 2; ++k) accx[n] = __builtin_amdgcn_mfma_f32_16x16x32_bf16(B0[n][k], Ax[k], accx[n], 0, 0, 0); } \
        else { _Pragma("unroll") for (int n = 0; n < 2; ++n) _Pragma("unroll") for (int k = 0; k < 2; ++k) accx[n] = __builtin_amdgcn_mfma_f32_16x16x32_bf16(B1[n][k], Ax[k], accx[n], 0, 0, 0); } __builtin_amdgcn_s_setprio(0); } while (0)
#define PG8_WAIT_V(n) asm volatile("s_waitcnt vmcnt(" #n ")" ::: "memory")
#define PG8_WAIT_L(n) asm volatile("s_waitcnt lgkmcnt(" #n ")" ::: "memory")
#define PG8_BAR __builtin_amdgcn_s_barrier()
#define PG8_SCHED __builtin_amdgcn_sched_barrier(0)
    Unit cur, nxt; int ui = 0;
    if (!S.next(0, cur)) return;
    f32x4 acc[2][2][4][2], accx[2];
#pragma unroll
    for (int a = 0; a < 2; ++a)
#pragma unroll
        for (int b = 0; b < 2; ++b)
#pragma unroll
            for (int m = 0; m < 4; ++m)
#pragma unroll
                for (int n = 0; n < 2; ++n) acc[a][b][m][n] = (f32x4){0.f, 0.f, 0.f, 0.f};
    accx[0] = (f32x4){0.f, 0.f, 0.f, 0.f}; accx[1] = (f32x4){0.f, 0.f, 0.f, 0.f};
    bf16x8 At[4][2], B0[2][2], B1[2][2], Ax[2];
    const char* cA = (const char*)g.A + (size_t)cur.pm * tstep; const char* cB = (const char*)g.Bt + (size_t)Epi::col_tile(cur.pn) * tstep; const char* cX = (const char*)g.AX + (size_t)cur.pm * xstep;
    S.a_ready(cur);
    PG8_STAGE(PG8_SB(0, 0), cB, voffB); PG8_STAGE(PG8_SB(0, 1), cB + hstep, voffB); PG8_STAGE(PG8_SA(0, 0), cA, voffA); PG8_STAGEX(0, cX); PG8_STAGE(PG8_SA(0, 1), cA + hstep, voffA);
    if (wr == 1) PG8_BAR;
    PG8_WAIT_V(2); PG8_BAR;
    PG8_STAGE(PG8_SB(1, 0), cB + kstep, voffB); PG8_STAGE(PG8_SA(1, 0), cA + kstep, voffA); PG8_STAGE(PG8_SB(1, 1), cB + hstep + kstep, voffB); PG8_STAGEX(1, cX + kstep);
    PG8_WAIT_V(7); PG8_BAR;
    for (;;) {
        const bool has_next = S.next(ui + 1, nxt);
        const char* nA = has_next ? (const char*)g.A + (size_t)nxt.pm * tstep : cA; const char* nB = has_next ? (const char*)g.Bt + (size_t)Epi::col_tile(nxt.pn) * tstep : cB; const char* nX = has_next ? (const char*)g.AX + (size_t)nxt.pm * xstep : cX;
        for (int t = 0; t < nt; t += 2) {
            const bool last = (t == nt - 2);
            const char* a1 = cA + (size_t)(t + 1) * kstep;
            const char* a2 = last ? nA : cA + (size_t)(t + 2) * kstep; const char* b2 = last ? nB : cB + (size_t)(t + 2) * kstep; const char* x2 = last ? nX : cX + (size_t)(t + 2) * kstep;
            const char* a3 = a2 + kstep; const char* b3 = b2 + kstep; const char* x3 = x2 + kstep;
            if (last && has_next) S.a_ready(nxt);
            PG8_LDB(B0, 0, 0); PG8_LDB(B1, 0, 1); PG8_SCHED; PG8_LDA(At, 0, 0); PG8_LDX(0); PG8_STAGE(PG8_SA(1, 1), a1 + hstep, voffA);
            PG8_WAIT_V(9); PG8_WAIT_L(0); PG8_BAR; PG8_MMA(0, 0, At, B0); PG8_MMA(0, 1, At, B1); PG8_MMAX(); PG8_BAR; PG8_SCHED;
            PG8_LDA(At, 0, 1); PG8_STAGE(PG8_SB(0, 0), b2, voffB); PG8_STAGE(PG8_SB(0, 1), b2 + hstep, voffB); PG8_STAGE(PG8_SA(0, 0), a2, voffA); PG8_STAGEX(0, x2);
            PG8_WAIT_V(9); PG8_WAIT_L(0); PG8_BAR; PG8_MMA(1, 0, At, B0); PG8_MMA(1, 1, At, B1); PG8_BAR; PG8_SCHED;
            PG8_LDB(B0, 1, 0); PG8_LDB(B1, 1, 1); PG8_SCHED; PG8_LDA(At, 1, 0); PG8_LDX(1); PG8_STAGE(PG8_SA(0, 1), a2 + hstep, voffA);
            PG8_WAIT_V(9); PG8_WAIT_L(0); PG8_BAR; PG8_MMA(0, 0, At, B0); PG8_MMA(0, 1, At, B1); PG8_MMAX(); PG8_BAR; PG8_SCHED;
            PG8_LDA(At, 1, 1); PG8_STAGE(PG8_SB(1, 0), b3, voffB); PG8_STAGE(PG8_SB(1, 1), b3 + hstep, voffB); PG8_STAGE(PG8_SA(1, 0), a3, voffA); PG8_STAGEX(1, x3);
            PG8_WAIT_V(9); PG8_WAIT_L(0); PG8_BAR; PG8_MMA(1, 0, At, B0); PG8_MMA(1, 1, At, B1); PG8_BAR; PG8_SCHED;
        }
        if (wr == 0) PG8_BAR;
        E(acc, accx, cur, wr, wc, fr, fq); S.done(cur);
        if (!has_next) break;
#pragma unroll
        for (int a = 0; a < 2; ++a)
#pragma unroll
            for (int b = 0; b < 2; ++b)
#pragma unroll
                for (int m = 0; m < 4; ++m)
#pragma unroll
                    for (int n = 0; n < 2; ++n) acc[a][b][m][n] = (f32x4){0.f, 0.f, 0.f, 0.f};
        accx[0] = (f32x4){0.f, 0.f, 0.f, 0.f}; accx[1] = (f32x4){0.f, 0.f, 0.f, 0.f};
        cur = nxt; cA = nA; cB = nB; cX = nX; ++ui;
        if (wr == 1) PG8_BAR;
    }
    PG8_WAIT_V(0);
    PG8_BAR;
#undef PG8_SA
#undef PG8_SB
#undef PG8_SX
#undef PG8_STAGE
#undef PG8_STAGEX
#undef PG8_LDA
#undef PG8_LDB
#undef PG8_LDX
#undef PG8_MMA
#undef PG8_MMAX
#undef PG8_WAIT_V
#undef PG8_WAIT_L
#undef PG8_BAR
#undef PG8_SCHED
}
}

#ifndef MK_PER_PHASE
#define MK_PER_PHASE 0
#endif

constexpr int D = 2048, MP = 8192, MS = 512, M = MP + MS;
constexpr int SEQ = 2048, NBP = 4, NBS = 128, TS = 4, NCOND = NBP + NBS, DEPTH = 4;
constexpr int DFF = 8192;
constexpr int HG_H = 16, HG_K = 128, HG_V = 128;
constexpr int GL_H = 4, GL_K = 256, GL_V = 512, GL_KD = 1024, GL_R = 16, GL_IN = 6160, GL_INP = 6144;
constexpr int CH = 64, NCH = SEQ / CH;
constexpr float ALPHA = 1.6817928305074290f;
constexpr float LN_EPS = 1e-5f;

constexpr size_t O_YP = 0, O_YS = O_YP + (size_t)MP * D, O_HGP = O_YS + (size_t)MS * D, O_GLP = O_HGP + (size_t)2 * NBP * HG_H * HG_K * HG_V,
                 O_HGS = O_GLP + (size_t)2 * NBP * GL_H * GL_K * GL_V, O_GLS = O_HGS + (size_t)2 * NBS * HG_H * HG_K * HG_V, O_END = O_GLS + (size_t)2 * NBS * GL_H * GL_K * GL_V;

constexpr size_t al(size_t x) { return (x + 4095) & ~(size_t)4095; }
constexpr size_t WS_CTL = 0, CTL_ZERO_BYTES = 1u << 20;
constexpr size_t WS_HGWI = CTL_ZERO_BYTES;
constexpr size_t WS_HGWO = WS_HGWI + (size_t)2 * 8192 * 2048 * 2;
constexpr size_t WS_GLWI = WS_HGWO + (size_t)2 * 2048 * 2048 * 2;
constexpr size_t WS_GLWO = WS_GLWI + (size_t)2 * GL_INP * 2048 * 2;
constexpr size_t WS_WUP  = WS_GLWO + (size_t)2 * 2048 * 2048 * 2;
constexpr size_t WS_WDN  = WS_WUP + (size_t)4 * 8192 * 2048 * 2;
constexpr size_t WS_MOD  = WS_WDN + (size_t)4 * 8192 * 2048 * 2;
constexpr size_t WS_LB   = al(WS_MOD + (size_t)NCOND * 4 * 6 * D * 4);
constexpr size_t WS_CS   = al(WS_LB + (size_t)2 * D * 4);
constexpr size_t WS_X    = al(WS_CS + (size_t)144 * D * 2);
constexpr size_t WS_Z    = WS_X + (size_t)M * D * 4;
constexpr size_t WS_H    = WS_Z + (size_t)M * D * 4;
constexpr size_t WS_O    = WS_H + (size_t)M * D * 2;
constexpr size_t WS_QB   = WS_O + (size_t)M * D * 2;
constexpr size_t WS_KB   = WS_QB + (size_t)M * D * 2;
constexpr size_t WS_VB   = WS_KB + (size_t)M * D * 2;
constexpr size_t WS_GB   = WS_VB + (size_t)M * D * 2;
constexpr size_t WS_LF   = WS_GB + (size_t)M * D * 2;
constexpr size_t WS_U    = WS_LF + (size_t)M * D * 4;
constexpr size_t WS_ST   = WS_U + (size_t)M * DFF * 2;
constexpr size_t WS_ORAW = WS_ST + (size_t)NBP * GL_H * NCH * GL_V * GL_K * 2;
constexpr size_t WS_END  = WS_ORAW + (size_t)MS * D * 4;
constexpr int CW_TMO = 0, CW_BAR = 4096, CW_Q = 16384;

constexpr int LDS_BYTES = 163840, MISC_OFF = LDS_BYTES - 128;

#define GAS __attribute__((address_space(1)))
#define LAS __attribute__((address_space(3)))
typedef unsigned short bf16;
typedef unsigned v4u __attribute__((ext_vector_type(4)));
typedef unsigned v2u __attribute__((ext_vector_type(2)));
typedef float f32x4 __attribute__((ext_vector_type(4)));
typedef short bf16x8 __attribute__((ext_vector_type(8)));
typedef GAS unsigned gu32;
#define RLX_AGENT __ATOMIC_RELAXED, __HIP_MEMORY_SCOPE_AGENT
#define LDS_WAIT() asm volatile("s_waitcnt lgkmcnt(0)" ::: "memory")
#define VM_WAIT() asm volatile("s_waitcnt vmcnt(0)" ::: "memory")
__device__ __forceinline__ unsigned pk2(float lo, float hi) { unsigned r; asm("v_cvt_pk_bf16_f32 %0, %1, %2" : "=v"(r) : "v"(lo), "v"(hi)); return r; }
__device__ __forceinline__ unsigned f2bf(float f) { return pk2(f, f) & 0xffffu; }
__device__ __forceinline__ float bf2f(unsigned short b) { return __builtin_bit_cast(float, (unsigned)b << 16); }
__device__ __forceinline__ float bflo(unsigned w) { return __builtin_bit_cast(float, w << 16); }
__device__ __forceinline__ float bfhi(unsigned w) { return __builtin_bit_cast(float, w & 0xffff0000u); }
__device__ __forceinline__ float fast_exp(float x) { return __builtin_amdgcn_exp2f(x * 1.4426950408889634f); }
__device__ __forceinline__ float fast_log(float x) { return __builtin_amdgcn_logf(x) * 0.6931471805599453f; }
__device__ __forceinline__ float silu_f(float v) { return v * __builtin_amdgcn_rcpf(1.0f + fast_exp(-v)); }
__device__ __forceinline__ float logsigmoid_f(float x) { return fminf(x, 0.f) - fast_log(1.0f + fast_exp(-fabsf(x))); }
__device__ __forceinline__ float wave_sum(float v) {
#pragma unroll
    for (int o = 1; o < 64; o <<= 1) v += __shfl_xor(v, o);
    return v;
}
__device__ __forceinline__ int cond_of_row(int r) { return r < MP ? (r >> 11) : NBP + ((r - MP) >> 2); }

#define XB_TMO      128
#define XB_XCNT(j)  (256  + 64 * (j))
#define XB_XSUB(j)  (1280 + 64 * (j))
#define XB_XGEN(j)  (2304 + 64 * (j))
#define XB_TOP      3328
#define XB_TOPGEN   3392
#define XCD_BAR_WORDS 3456
#define XB_SPIN_CAP (1u << 18)
#define LAS __attribute__((address_space(3)))

__device__ __forceinline__ unsigned xb_ld(unsigned* p)              { return __hip_atomic_load(p, __ATOMIC_RELAXED, __HIP_MEMORY_SCOPE_AGENT); }
__device__ __forceinline__ unsigned xb_add(unsigned* p, unsigned v) { return __hip_atomic_fetch_add(p, v, __ATOMIC_RELAXED, __HIP_MEMORY_SCOPE_AGENT); }
__device__ __forceinline__ unsigned xb_xcc_id() { return (unsigned)__builtin_amdgcn_s_getreg((3 << 11) | 20) & 0xFu; }
#define XB_SPIN(cond, bar) do { unsigned _sp = 0; while (cond) { __builtin_amdgcn_s_sleep(1); \
    if ((++_sp & 255u) == 0u) { if (xb_ld(&(bar)[XB_TMO])) break; if (_sp > XB_SPIN_CAP) { atomicAdd(&(bar)[XB_TMO], 1u); break; } } } } while (0)

struct XcdBarrier {
    unsigned* bar; unsigned x;
    volatile LAS unsigned* st;
};

__device__ __forceinline__ XcdBarrier xcd_barrier_post(unsigned* bar, volatile LAS unsigned* st) {
    XcdBarrier b; b.bar = bar; b.x = xb_xcc_id(); b.st = st;
    if (threadIdx.x == 0) (void)xb_add(&bar[XB_XCNT(b.x)], 1u);
    return b;
}
__device__ __forceinline__ void xcd_barrier_complete(unsigned* bar, unsigned x, unsigned& nloc, unsigned& nx) {
    const unsigned G = gridDim.x * gridDim.y * gridDim.z;
    unsigned sum, cnt, mine, sp = 0u;
    for (;;) {
        sum = 0u; cnt = 0u; mine = 0u;
#pragma unroll
        for (unsigned j = 0; j < 16; ++j) { const unsigned c = xb_ld(&bar[XB_XCNT(j)]); sum += c; cnt += (c > 0u) ? 1u : 0u; mine = (j == x) ? c : mine; }
        if (sum == G) break;
        __builtin_amdgcn_s_sleep(1);
        if ((++sp & 255u) == 0u) { if (xb_ld(&bar[XB_TMO])) break; if (sp > XB_SPIN_CAP) { atomicAdd(&bar[XB_TMO], 1u); break; } }
    }
    nloc = mine > 0u ? mine : 1u; nx = cnt > 0u ? cnt : 1u;
}

__device__ __forceinline__ void xcd_barrier(const XcdBarrier& b) {
    asm volatile("s_waitcnt vmcnt(0)" ::: "memory");
    __syncthreads();
    if (threadIdx.x == 0) {
        unsigned* bar = b.bar;
        __builtin_amdgcn_s_waitcnt(0);
        unsigned nloc = b.st[0], nx = b.st[1];
        if (nloc == 0u) { xcd_barrier_complete(bar, b.x, nloc, nx); b.st[0] = nloc; b.st[1] = nx; }
        const unsigned old = xb_add(&bar[XB_XSUB(b.x)], 1u);
        const unsigned gen = old / nloc;
        if (old + 1u == (gen + 1u) * nloc) {
            __builtin_amdgcn_fence(__ATOMIC_RELEASE, "agent");
            asm volatile("s_waitcnt vmcnt(0)" ::: "memory");
            const unsigned og = xb_add(&bar[XB_TOP], 1u);
            const unsigned tg = og / nx;
            if (og + 1u == (tg + 1u) * nx) xb_add(&bar[XB_TOPGEN], 1u);
            else XB_SPIN(xb_ld(&bar[XB_TOPGEN]) == tg, bar);
            __builtin_amdgcn_fence(__ATOMIC_ACQUIRE, "agent");
            xb_add(&bar[XB_XGEN(b.x)], 1u);
            asm volatile("s_waitcnt vmcnt(0)" ::: "memory");
        } else {
            XB_SPIN(xb_ld(&bar[XB_XGEN(b.x)]) == gen, bar);
            __builtin_amdgcn_fence(__ATOMIC_ACQUIRE, "agent");
            asm volatile("s_waitcnt vmcnt(0)" ::: "memory");
        }
    }
    __syncthreads();
}

using pg8::cvt_pk_bf16;

struct EpiHgIn {
    static constexpr bool PERM = true, AFTER_DRAIN = false;
    bf16 *QB; float* LF; const float* lb;
    static __device__ __forceinline__ int col_tile(int pn) { return ((pn >> 2) & 3) * 8 + (pn & 3) + 4 * (pn >> 4); }
    __device__ __forceinline__ void put_f(int row, int c, const f32x4& a0, const f32x4& a1, const f32x4& l0, const f32x4& l1) const {
        const size_t off = (size_t)row * D + c;
        const float fpv[8] = {a0[0], a0[1], a0[2], a0[3], a1[0], a1[1], a1[2], a1[3]};
        const float lbs[8] = {l0[0], l0[1], l0[2], l0[3], l1[0], l1[1], l1[2], l1[3]};
        float lf[8], kk[8];
#pragma unroll
        for (int i = 0; i < 8; ++i) {
            const float fp = fpv[i], lbv = lbs[i];
            const float e = fast_exp(-fabsf(fp)), inv = __builtin_amdgcn_rcpf(1.0f + e);
            const float sig = fp >= 0.f ? inv : e * inv, nsig = fp >= 0.f ? e * inv : inv;
            const bool pos = lbv > 0.f;
            const float lg = fast_log(pos ? lbv + (1.0f - lbv) * sig : 1.0f + e);
            lf[i] = pos ? lg : fminf(fp, 0.f) - lg;
            kk[i] = (1.0f - lbv) * nsig;
        }
        *(f32x4*)(LF + off) = (f32x4){lf[0], lf[1], lf[2], lf[3]};
        *(f32x4*)(LF + off + 4) = (f32x4){lf[4], lf[5], lf[6], lf[7]};
        v4u w; w.x = cvt_pk_bf16(kk[0], kk[1]); w.y = cvt_pk_bf16(kk[2], kk[3]); w.z = cvt_pk_bf16(kk[4], kk[5]); w.w = cvt_pk_bf16(kk[6], kk[7]);
        *(v4u*)(QB + (size_t)M * D + off) = w;
    }
    __device__ __forceinline__ void put_o(bf16* dst, bool act, int row, int c, const f32x4& a0, const f32x4& a1) const {
        const float v[8] = {a0[0], a0[1], a0[2], a0[3], a1[0], a1[1], a1[2], a1[3]};
        float x[8];
#pragma unroll
        for (int i = 0; i < 8; ++i) x[i] = act ? silu_f(v[i]) : v[i];
        v4u w; w.x = cvt_pk_bf16(x[0], x[1]); w.y = cvt_pk_bf16(x[2], x[3]); w.z = cvt_pk_bf16(x[4], x[5]); w.w = cvt_pk_bf16(x[6], x[7]);
        *(v4u*)(dst + (size_t)row * D + c) = w;
    }
    __device__ __forceinline__ void operator()(const pg8::f32x4 (&acc)[2][2][4][2], const pg8::f32x4 (&accx)[2], const pg8::Unit& u, int wr, int wc, int fr, int fq) const {
        const int pn = col_tile(u.pn), row0 = u.pm * 256 + wr * 64 + fr, sec = pn >> 3, col0 = (pn & 7) * 256 + wc * 32 + 8 * fq, rowx = MP + u.pm * 16 + fr;
        if (sec == 1) {
#pragma unroll
            for (int bj = 0; bj < 2; ++bj) {
                const int c = col0 + bj * 128;
                const f32x4 l0 = *(const f32x4*)(lb + c), l1 = *(const f32x4*)(lb + c + 4);
#pragma unroll
                for (int ai = 0; ai < 2; ++ai)
#pragma unroll
                    for (int m = 0; m < 4; ++m) put_f(row0 + ai * 128 + m * 16, c, acc[ai][bj][m][0], acc[ai][bj][m][1], l0, l1);
            }
            { const int c = col0 + wr * 128; const f32x4 l0 = *(const f32x4*)(lb + c), l1 = *(const f32x4*)(lb + c + 4); put_f(rowx, c, accx[0], accx[1], l0, l1); }
        } else {
            bf16* dst = QB + (size_t)sec * ((size_t)M * D);
            const bool act = sec != 2;
#pragma unroll
            for (int ai = 0; ai < 2; ++ai)
#pragma unroll
                for (int m = 0; m < 4; ++m)
#pragma unroll
                    for (int bj = 0; bj < 2; ++bj) put_o(dst, act, row0 + ai * 128 + m * 16, col0 + bj * 128, acc[ai][bj][m][0], acc[ai][bj][m][1]);
            put_o(dst, act, rowx, col0 + wr * 128, accx[0], accx[1]);
        }
    }
};

struct EpiGlaIn {
    static constexpr bool PERM = true, AFTER_DRAIN = false;
    static __device__ __forceinline__ int col_tile(int pn) { return pn; }
    bf16 *QB;
    __device__ __forceinline__ void put_o(bf16* dst, int ld, bool act, float sc, int row, int c, const f32x4& a0, const f32x4& a1) const {
        const float v[8] = {a0[0], a0[1], a0[2], a0[3], a1[0], a1[1], a1[2], a1[3]};
        float x[8];
#pragma unroll
        for (int i = 0; i < 8; ++i) x[i] = act ? silu_f(v[i]) : v[i] * sc;
        v4u w; w.x = cvt_pk_bf16(x[0], x[1]); w.y = cvt_pk_bf16(x[2], x[3]); w.z = cvt_pk_bf16(x[4], x[5]); w.w = cvt_pk_bf16(x[6], x[7]);
        *(v4u*)(dst + (size_t)row * ld + c) = w;
    }
    __device__ __forceinline__ void operator()(const pg8::f32x4 (&acc)[2][2][4][2], const pg8::f32x4 (&accx)[2], const pg8::Unit& u, int wr, int wc, int fr, int fq) const {
        const int row0 = u.pm * 256 + wr * 64 + fr, pn = u.pn, rowx = MP + u.pm * 16 + fr;
        int which, ld, colt; float sc = 1.f; bool act = false;
        if (pn < 4) { which = 0; ld = GL_KD; colt = pn * 256; sc = 0.0625f; }
        else if (pn < 8) { which = 1; ld = GL_KD; colt = (pn - 4) * 256; }
        else if (pn < 16) { which = 2; ld = D; colt = (pn - 8) * 256; }
        else { which = 3; ld = D; colt = (pn - 16) * 256; act = true; }
        bf16* dst = QB + (size_t)which * ((size_t)M * D);
        const int col0 = colt + wc * 32 + 8 * fq;
#pragma unroll
        for (int ai = 0; ai < 2; ++ai)
#pragma unroll
            for (int m = 0; m < 4; ++m)
#pragma unroll
                for (int bj = 0; bj < 2; ++bj) put_o(dst, ld, act, sc, row0 + ai * 128 + m * 16, col0 + bj * 128, acc[ai][bj][m][0], acc[ai][bj][m][1]);
        put_o(dst, ld, act, sc, rowx, col0 + wr * 128, accx[0], accx[1]);
    }
};

struct EpiUp {
    static constexpr bool PERM = true, AFTER_DRAIN = false;
    static __device__ __forceinline__ int col_tile(int pn) { return pn; }
    bf16* U;
    __device__ __forceinline__ void put_o(int row, int c, const f32x4& a0, const f32x4& a1) const {
        const float v[8] = {a0[0], a0[1], a0[2], a0[3], a1[0], a1[1], a1[2], a1[3]};
        float x[8];
#pragma unroll
        for (int i = 0; i < 8; ++i) { const float r = fmaxf(v[i], 0.f); x[i] = r * r; }
        v4u w; w.x = cvt_pk_bf16(x[0], x[1]); w.y = cvt_pk_bf16(x[2], x[3]); w.z = cvt_pk_bf16(x[4], x[5]); w.w = cvt_pk_bf16(x[6], x[7]);
        *(v4u*)(U + (size_t)row * DFF + c) = w;
    }
    __device__ __forceinline__ void operator()(const pg8::f32x4 (&acc)[2][2][4][2], const pg8::f32x4 (&accx)[2], const pg8::Unit& u, int wr, int wc, int fr, int fq) const {
        const int row0 = u.pm * 256 + wr * 64 + fr, col0 = u.pn * 256 + wc * 32 + 8 * fq;
#pragma unroll
        for (int ai = 0; ai < 2; ++ai)
#pragma unroll
            for (int m = 0; m < 4; ++m)
#pragma unroll
                for (int bj = 0; bj < 2; ++bj) put_o(row0 + ai * 128 + m * 16, col0 + bj * 128, acc[ai][bj][m][0], acc[ai][bj][m][1]);
        put_o(MP + u.pm * 16 + fr, col0 + wr * 128, accx[0], accx[1]);
    }
};

struct EpiRes {
    static constexpr bool PERM = false, AFTER_DRAIN = false;
    static __device__ __forceinline__ int col_tile(int pn) { return pn; }
    const float* X; float* Z; const float* gate;
    __device__ __forceinline__ void put(int row, int c, const f32x4& a) const {
        const f32x4 gv = *(const f32x4*)(gate + (size_t)cond_of_row(row) * (4 * 6 * D) + c), xv = *(const f32x4*)(X + (size_t)row * D + c);
        *(f32x4*)(Z + (size_t)row * D + c) = xv * ALPHA + (gv + 1.0f) * a;
    }
    __device__ __forceinline__ void operator()(const pg8::f32x4 (&acc)[2][2][4][2], const pg8::f32x4 (&accx)[2], const pg8::Unit& u, int wr, int wc, int fr, int fq) const {
        const int row0 = u.pm * 256 + wr * 64 + fr, col0 = u.pn * 256 + wc * 32 + 4 * fq;
#pragma unroll
        for (int ai = 0; ai < 2; ++ai)
#pragma unroll
            for (int m = 0; m < 4; ++m)
#pragma unroll
                for (int bj = 0; bj < 2; ++bj)
#pragma unroll
                    for (int n = 0; n < 2; ++n) put(row0 + ai * 128 + m * 16, col0 + bj * 128 + n * 16, acc[ai][bj][m][n]);
#pragma unroll
        for (int n = 0; n < 2; ++n) put(MP + u.pm * 16 + fr, col0 + wr * 128 + n * 16, accx[n]);
    }
};

struct Args { const float* in[21]; float* out; unsigned char* ws; int ph_lo, ph_hi; };
typedef const __attribute__((address_space(4))) Args* KArgs;
struct Frame {
    LAS unsigned char* lds;
    volatile LAS unsigned* MISC;
    int tid, lane, wave;
    int vcu, G, bx;
    unsigned char* ws;
    KArgs ka;
    float* out;
};
constexpr int NWAVES = 8, NT = 512;
__device__ __forceinline__ Frame mk_frame() {
    extern __shared__ __attribute__((aligned(16))) unsigned char lds_base[];
    Frame F;
    int tid = threadIdx.x; asm volatile("" : "+v"(tid));
    int bx = blockIdx.x, G = gridDim.x; asm volatile("" : "+s"(bx), "+s"(G));
    KArgs ka = (KArgs)__builtin_amdgcn_kernarg_segment_ptr(); asm volatile("" : "+s"(ka));
    F.lds = (LAS unsigned char*)lds_base; F.MISC = (volatile LAS unsigned*)(F.lds + MISC_OFF);
    F.tid = tid; F.lane = tid & 63; F.wave = __builtin_amdgcn_readfirstlane(tid >> 6);
    F.G = G; F.bx = bx; F.vcu = (G % 8 == 0) ? (bx % 8) * (G / 8) + bx / 8 : bx;
    F.ka = ka; F.ws = ka->ws; F.out = ka->out;
    return F;
}

struct TrItem { const float* W; bf16* WT; int K, ld, k0, n0; };
__device__ __forceinline__ void tr_load(const TrItem& t, int lane, float (&wv)[32]) {
    const float* base = t.W + (size_t)t.k0 * t.ld + t.n0;
    const int off = (lane >> 5) * t.ld + (lane & 31);
#pragma unroll
    for (int i = 0; i < 32; ++i) wv[i] = base[(size_t)(2 * i) * t.ld + off];
}
__device__ __forceinline__ void tr_store(const TrItem& t, int lane, const float (&wv)[32], LAS float* scr) {
#pragma unroll
    for (int i = 0; i < 32; ++i) scr[(2 * i + (lane >> 5)) * 33 + (lane & 31)] = wv[i];
    LDS_WAIT(); asm volatile("" ::: "memory");
    const int c = lane & 7;
#pragma unroll
    for (int j = 0; j < 4; ++j) { const int n = (lane >> 3) + 8 * j; const LAS float* s = scr + (8 * c) * 33 + n;
        v4u o; o.x = pg8::cvt_pk_bf16(s[0 * 33], s[1 * 33]); o.y = pg8::cvt_pk_bf16(s[2 * 33], s[3 * 33]); o.z = pg8::cvt_pk_bf16(s[4 * 33], s[5 * 33]); o.w = pg8::cvt_pk_bf16(s[6 * 33], s[7 * 33]);
        *(GAS v4u*)(t.WT + (size_t)(t.n0 + n) * t.K + t.k0 + 8 * c) = o; }
    LDS_WAIT(); asm volatile("" ::: "memory");
}

__device__ __forceinline__ void phase_p0(Frame& F) {
    const int gt = F.vcu * NT + F.tid, NGT = F.G * NT;
    bf16* CS = (bf16*)(F.ws + WS_CS);
    for (int i = gt; i < 144 * D; i += NGT) {
        const int r = i / D, c = i % D; float v = 0.f;
        if (r < NBP) v = F.ka->in[4][(size_t)r * D + c]; else if (r < NCOND) v = F.ka->in[5][(size_t)(r - NBP) * D + c];
        CS[i] = (bf16)f2bf(r < NCOND ? silu_f(v) : 0.f);
    }
    float* LB = (float*)(F.ws + WS_LB);
    for (int c = gt; c < D; c += NGT) {
        const float a0 = F.ka->in[11][c], a1 = F.ka->in[11][D + c], mx = fmaxf(a0, a1);
        const float e0 = expf(a0 - mx), e1 = expf(a1 - mx), s = e0 + e1, p0 = e0 / s, p1 = e1 / s;
        LB[c] = fminf(fmaxf(p0 - p0, 0.f), 1.0f - 1e-6f);
        LB[D + c] = fminf(fmaxf((p0 + p1) - p0, 0.f), 1.0f - 1e-6f);
    }
}

__device__ __forceinline__ void phase_p1(Frame& F) {
    {
        const bf16* CS = (const bf16*)(F.ws + WS_CS);
        float* MOD = (float*)(F.ws + WS_MOD);
        const int fr = F.lane & 15, fq = F.lane >> 4, nt = F.wave & 3, kh = F.wave >> 2;
        LAS float* red = (LAS float*)F.lds;
        for (int it = F.vcu; it < (DEPTH * 6 * D) / 64; it += F.G) {
            const int nn = it * 64, l = nn / (6 * D), c0 = nn % (6 * D) + 16 * nt;
            const float* W = F.ka->in[6] + (size_t)l * D * (6 * D) + c0 + fr;
            f32x4 acc[9];
#pragma unroll
            for (int rt = 0; rt < 9; ++rt) acc[rt] = (f32x4){0.f, 0.f, 0.f, 0.f};
            for (int ks4 = 0; ks4 < 32; ks4 += 4) {
                float w[4][8];
#pragma unroll
                for (int q = 0; q < 4; ++q)
#pragma unroll
                    for (int j = 0; j < 8; ++j) w[q][j] = W[(size_t)(kh * 1024 + (ks4 + q) * 32 + 8 * fq + j) * (6 * D)];
#pragma unroll
                for (int q = 0; q < 4; ++q) {
                    const int k0 = kh * 1024 + (ks4 + q) * 32 + 8 * fq;
                    v4u bw; bw.x = pk2(w[q][0], w[q][1]); bw.y = pk2(w[q][2], w[q][3]); bw.z = pk2(w[q][4], w[q][5]); bw.w = pk2(w[q][6], w[q][7]);
                    const bf16x8 bfrag = __builtin_bit_cast(bf16x8, bw);
#pragma unroll
                    for (int rt = 0; rt < 9; ++rt) {
                        const bf16x8 afrag = *(const bf16x8*)(CS + (size_t)(16 * rt + fr) * D + k0);
                        acc[rt] = __builtin_amdgcn_mfma_f32_16x16x32_bf16(afrag, bfrag, acc[rt], 0, 0, 0);
                    }
                }
            }
            if (kh == 1) {
#pragma unroll
                for (int rt = 0; rt < 9; ++rt) *(LAS f32x4*)(red + ((nt * 9 + rt) * 64 + F.lane) * 4) = acc[rt];
            }
            __syncthreads();
            if (kh == 0) {
                const float bias = F.ka->in[7][(size_t)l * (6 * D) + c0 + fr];
#pragma unroll
                for (int rt = 0; rt < 9; ++rt) {
                    const f32x4 o = acc[rt] + *(LAS f32x4*)(red + ((nt * 9 + rt) * 64 + F.lane) * 4);
#pragma unroll
                    for (int j = 0; j < 4; ++j) { const int row = 16 * rt + 4 * fq + j; if (row < NCOND) MOD[((size_t)row * DEPTH + l) * (6 * D) + c0 + fr] = o[j] + bias; }
                }
            }
            __syncthreads();
        }
    }
    LAS float* scr = (LAS float*)(F.lds + F.wave * 16384);
    const int gw = F.vcu * NWAVES + F.wave, NGW = F.G * NWAVES;
    constexpr int I_HGI = 32 * 256, I_SQ = 32 * 64, I_GLI = 32 * 192, I_UP = 32 * 256, I_DN = 128 * 64;
    constexpr int NITEMS = 2 * (I_HGI + I_SQ + I_GLI + I_SQ) + 4 * (I_UP + I_DN);
    auto decode = [&](int it) -> TrItem {
        TrItem t; int r = it, item, ncols;
        if (r < 2 * I_HGI) { const int j = r / I_HGI; t.W = F.ka->in[10] + (size_t)j * D * 8192; t.K = D; t.ld = 8192; ncols = 8192; t.WT = (bf16*)(F.ws + WS_HGWI) + (size_t)j * 8192 * D; item = r % I_HGI; }
        else if ((r -= 2 * I_HGI) < 2 * I_SQ) { const int j = r / I_SQ; t.W = F.ka->in[13] + (size_t)j * D * D; t.K = D; t.ld = D; ncols = D; t.WT = (bf16*)(F.ws + WS_HGWO) + (size_t)j * D * D; item = r % I_SQ; }
        else if ((r -= 2 * I_SQ) < 2 * I_GLI) { const int j = r / I_GLI; t.W = F.ka->in[14] + (size_t)j * D * GL_IN; t.K = D; t.ld = GL_IN; ncols = 6144; t.WT = (bf16*)(F.ws + WS_GLWI) + (size_t)j * GL_INP * D; item = r % I_GLI; }
        else if ((r -= 2 * I_GLI) < 2 * I_SQ) { const int j = r / I_SQ; t.W = F.ka->in[18] + (size_t)j * D * D; t.K = D; t.ld = D; ncols = D; t.WT = (bf16*)(F.ws + WS_GLWO) + (size_t)j * D * D; item = r % I_SQ; }
        else if ((r -= 2 * I_SQ) < 4 * I_UP) { const int l = r / I_UP; t.W = F.ka->in[19] + (size_t)l * D * DFF; t.K = D; t.ld = DFF; ncols = DFF; t.WT = (bf16*)(F.ws + WS_WUP) + (size_t)l * DFF * D; item = r % I_UP; }
        else { r -= 4 * I_UP; const int l = r / I_DN; t.W = F.ka->in[20] + (size_t)l * DFF * D; t.K = DFF; t.ld = D; ncols = D; t.WT = (bf16*)(F.ws + WS_WDN) + (size_t)l * D * DFF; item = r % I_DN; }
        const int nblk = ncols / 32; t.k0 = 64 * (item / nblk); t.n0 = 32 * (item % nblk);
        return t;
    };
    if (gw < NITEMS) {
        TrItem cur = decode(gw); float wv[32]; tr_load(cur, F.lane, wv);
        for (int it = gw; it < NITEMS; it += NGW) {
            const bool more = it + NGW < NITEMS;
            TrItem nxt = cur; float wn[32];
            if (more) { nxt = decode(it + NGW); tr_load(nxt, F.lane, wn); }
            tr_store(cur, F.lane, wv, scr);
            if (more) { cur = nxt;
#pragma unroll
                for (int i = 0; i < 32; ++i) wv[i] = wn[i]; }
        }
    }
}

__device__ __forceinline__ void row_load(const float* p, int lane, f32x4 (&v)[8]) {
    const GAS f32x4* xr = (const GAS f32x4*)p + lane;
#pragma unroll
    for (int j = 0; j < 8; ++j) v[j] = xr[64 * j];
}
__device__ __forceinline__ void row_modulate_store(const f32x4 (&x)[8], const float* sc, const float* sh, bf16* hrow, int lane) {
    GAS v2u* o8 = (GAS v2u*)hrow + lane;
#pragma unroll
    for (int j = 0; j < 8; ++j) {
        const f32x4 s = *((const GAS f32x4*)sc + lane + 64 * j), b = *((const GAS f32x4*)sh + lane + 64 * j);
        const f32x4 h = x[j] * (s + 1.0f) + b;
        v2u w; w.x = pk2(h[0], h[1]); w.y = pk2(h[2], h[3]); o8[64 * j] = w;
    }
}
__device__ __forceinline__ void phase_p2(Frame& F) {
    const int gw = F.vcu * NWAVES + F.wave, NGW = F.G * NWAVES;
    float* X = (float*)(F.ws + WS_X); bf16* H = (bf16*)(F.ws + WS_H); const float* MOD = (const float*)(F.ws + WS_MOD);
    for (int r = gw; r < M; r += NGW) {
        const float* src = r < MP ? F.ka->in[0] + (size_t)r * D : F.ka->in[1] + (size_t)(r - MP) * D;
        f32x4 v[8]; row_load(src, F.lane, v);
        GAS f32x4* xo = (GAS f32x4*)(X + (size_t)r * D) + F.lane;
#pragma unroll
        for (int j = 0; j < 8; ++j) xo[64 * j] = v[j];
        const float* md = MOD + (size_t)cond_of_row(r) * (DEPTH * 6 * D);
        row_modulate_store(v, md + D, md, H + (size_t)r * D, F.lane);
    }
}
template <bool GKL> __device__ __forceinline__ void phase_ln(Frame& F, const float* lnw, const float* lnb, int sc_off, int sh_off, bool last, int jg) {
    const int gw = F.vcu * NWAVES + F.wave, NGW = F.G * NWAVES, lane = F.lane;
    const float* Z = (const float*)(F.ws + WS_Z); float* X = (float*)(F.ws + WS_X); bf16* H = (bf16*)(F.ws + WS_H); const float* MOD = (const float*)(F.ws + WS_MOD);
    LAS bf16* WgL = (LAS bf16*)F.lds; LAS float* W2 = (LAS float*)(F.lds + 65536);
    const float* bgk = nullptr; float* LFo = nullptr;
    if constexpr (GKL) {
        const float* Wg = F.ka->in[14] + (size_t)jg * D * GL_IN + 6144;
        {
            f32x4 wv[16], w2v[8];
#pragma unroll
            for (int u = 0; u < 16; ++u) { const int i = F.tid + NT * u, k = i >> 2, q = i & 3; wv[u] = *(const f32x4*)(Wg + (size_t)k * GL_IN + 4 * q); }
            const float* w2 = F.ka->in[15] + (size_t)jg * GL_R * GL_KD;
#pragma unroll
            for (int u = 0; u < 8; ++u) w2v[u] = *(const f32x4*)(w2 + 4 * (F.tid + NT * u));
#pragma unroll
            for (int u = 0; u < 16; ++u) { const int i = F.tid + NT * u, k = i >> 2, q = i & 3, l = (k & 255) >> 2, e = k & 3, j = k >> 8;
                v2u w; w.x = pk2(wv[u][0], wv[u][1]); w.y = pk2(wv[u][2], wv[u][3]); *(LAS v2u*)(WgL + (((j * 4 + e) * 64) + l) * 16 + 4 * q) = w; }
#pragma unroll
            for (int u = 0; u < 8; ++u) *(LAS f32x4*)(W2 + 4 * (F.tid + NT * u)) = w2v[u];
        }
        bgk = F.ka->in[16] + (size_t)jg * GL_KD; LFo = (float*)(F.ws + WS_LF);
        __syncthreads();
    }
    for (int r = gw; r < M; r += NGW) {
        f32x4 v[8]; row_load(Z + (size_t)r * D, lane, v);
        float s = 0.f;
#pragma unroll
        for (int j = 0; j < 8; ++j) s += (v[j][0] + v[j][1]) + (v[j][2] + v[j][3]);
        const float mean = wave_sum(s) * (1.0f / D); float s2 = 0.f;
#pragma unroll
        for (int j = 0; j < 8; ++j) { v[j] = v[j] - mean; s2 += (v[j][0] * v[j][0] + v[j][1] * v[j][1]) + (v[j][2] * v[j][2] + v[j][3] * v[j][3]); }
        const float rstd = 1.0f / sqrtf(wave_sum(s2) * (1.0f / D) + LN_EPS);
#pragma unroll
        for (int j = 0; j < 8; ++j) {
            const f32x4 w = *((const GAS f32x4*)lnw + lane + 64 * j), b = *((const GAS f32x4*)lnb + lane + 64 * j);
            v[j] = v[j] * rstd * w + b;
        }
        float* dst = last ? (r < MP ? F.out + O_YP + (size_t)r * D : F.out + O_YS + (size_t)(r - MP) * D) : X + (size_t)r * D;
        GAS f32x4* xo = (GAS f32x4*)dst + lane;
#pragma unroll
        for (int j = 0; j < 8; ++j) xo[64 * j] = v[j];
        if (!last) {
            const float* md = MOD + (size_t)cond_of_row(r) * (DEPTH * 6 * D);
            const float* sc = md + sc_off; const float* sh = md + sh_off;
            GAS v2u* o8 = (GAS v2u*)(H + (size_t)r * D) + lane;
            float p[16];
#pragma unroll
            for (int q = 0; q < 16; ++q) p[q] = 0.f;
#pragma unroll
            for (int j = 0; j < 8; ++j) {
                const f32x4 sv = *((const GAS f32x4*)sc + lane + 64 * j), bv = *((const GAS f32x4*)sh + lane + 64 * j);
                const f32x4 h = v[j] * (sv + 1.0f) + bv;
                v2u w; w.x = pk2(h[0], h[1]); w.y = pk2(h[2], h[3]); o8[64 * j] = w;
                if constexpr (GKL) {
#pragma unroll
                    for (int e = 0; e < 4; ++e) {
                        const LAS v4u* wp = (const LAS v4u*)(WgL + (((j * 4 + e) * 64) + lane) * 16);
                        const v4u w0 = wp[0], w1 = wp[1];
                        const float hv = h[e];
                        p[0] += hv * bflo(w0.x); p[1] += hv * bfhi(w0.x); p[2] += hv * bflo(w0.y); p[3] += hv * bfhi(w0.y);
                        p[4] += hv * bflo(w0.z); p[5] += hv * bfhi(w0.z); p[6] += hv * bflo(w0.w); p[7] += hv * bfhi(w0.w);
                        p[8] += hv * bflo(w1.x); p[9] += hv * bfhi(w1.x); p[10] += hv * bflo(w1.y); p[11] += hv * bfhi(w1.y);
                        p[12] += hv * bflo(w1.z); p[13] += hv * bfhi(w1.z); p[14] += hv * bflo(w1.w); p[15] += hv * bfhi(w1.w);
                    }
                    asm volatile("" : "+v"(p[0]), "+v"(p[1]), "+v"(p[2]), "+v"(p[3]), "+v"(p[4]), "+v"(p[5]), "+v"(p[6]), "+v"(p[7]), "+v"(p[8]), "+v"(p[9]), "+v"(p[10]), "+v"(p[11]), "+v"(p[12]), "+v"(p[13]), "+v"(p[14]), "+v"(p[15]) :: "memory");
                }
            }
            if constexpr (GKL) {
#pragma unroll
                for (int q = 0; q < 16; ++q) p[q] = wave_sum(p[q]);
#pragma unroll
                for (int e2 = 0; e2 < 16; ++e2) {
                    const int c = lane + 64 * e2;
                    float x = bgk[c];
#pragma unroll
                    for (int q = 0; q < 16; ++q) x += p[q] * W2[q * GL_KD + c];
                    asm volatile("" : "+v"(x) :: "memory");
                    LFo[(size_t)r * GL_KD + c] = logsigmoid_f(x) * 0.0625f;
                }
            }
        }
    }
}

template <bool GLA> struct RecCfg {
    static constexpr int K = GLA ? GL_K : HG_K, V = GLA ? GL_V : HG_V, H = GLA ? GL_H : HG_H;
    static constexpr int LDQK = GLA ? GL_KD : D;
    static constexpr int LDLF = GLA ? GL_KD : D;
    static constexpr int SSEG = NT / K, L = CH / SSEG;
    static constexpr int KP = K + 8;
    static constexpr int SP = CH + 8;
};
struct RecArgs {
    const bf16 *QB, *KB, *VB, *GB; const float* LF;
    bf16* O; bf16* ST; float* ORAW;
    const float* normw;
    const float* s_in; float* s_out_sample; float* s_out_prompt;
    unsigned* queue;
};
__device__ __forceinline__ float clamp_exp(float x) { return fast_exp(fminf(x, 80.f)); }

template <bool GLA> __device__ __forceinline__ void rec_pass_a(Frame& F, const RecArgs& A) {
    typedef RecCfg<GLA> C; constexpr int K = C::K, V = C::V, H = C::H, LDQK = C::LDQK, LDLF = C::LDLF;
    constexpr int KS = K / 16, VQ = V / 64, NSI = NBP * H * KS * VQ;
    constexpr int CPL = 4, VWS = 128, LPR = VWS / 4, RPW = 64 / LPR, VP = V / VWS, NST = NBS * H * VP, KPL = K / 64, UN = 16;
    const int lane = F.lane, wave = F.wave, fr = lane & 15, fq = lane >> 4;
    LAS unsigned* cnt = (LAS unsigned*)F.lds;
    LAS float* vec = (LAS float*)(F.lds + 1024 + wave * 12288);
    if (F.tid == 0) *cnt = 0u;
    __syncthreads();
#ifndef REP_SCAN
#define REP_SCAN 1
#endif
#ifndef REP_STREAM
#define REP_STREAM 1
#endif
    _Pragma("nounroll") for (int rep_s = 0; rep_s < REP_SCAN; ++rep_s)
    for (int it = (F.vcu * NWAVES + wave); it < NSI; it += F.G * NWAVES) {
        const int vq = it % VQ, ks = (it / VQ) % KS, h = (it / (VQ * KS)) % H, b = it / (VQ * KS * H);
        const int kcol = h * K + 16 * ks + fr;
        const int vcol = h * V + vq * 64 + 4 * fr;
        f32x4 S[4];
#pragma unroll
        for (int i = 0; i < 4; ++i) S[i] = (f32x4){0.f, 0.f, 0.f, 0.f};
        bf16* STi = A.ST + (size_t)((b * H + h) * NCH) * V * K + ((size_t)ks * V + vq * 64 + 4 * fr) * 16 + 4 * fq;
        float l0[8], l1[8], k0[8], k1[8]; v2u vr0[8], vr1[8];
        const int loff = 8 * fq * LDLF + kcol, koff = 8 * fq * LDQK + kcol, voff = 8 * fq * D + vcol;
#define SCAN_LOAD(c_) do { const int Rc_ = b * SEQ + (c_) * CH; _Pragma("unroll") for (int i = 0; i < 8; ++i) { \
            const float* lfb_ = A.LF + (size_t)(Rc_ + i) * LDLF; const bf16* kb_ = A.KB + (size_t)(Rc_ + i) * LDQK; const bf16* vb_ = A.VB + (size_t)(Rc_ + i) * D; \
            l0[i] = lfb_[loff]; l1[i] = lfb_[32 * LDLF + loff]; k0[i] = bf2f(kb_[koff]); k1[i] = bf2f(kb_[32 * LDQK + koff]); \
            vr0[i] = *(const v2u*)(vb_ + voff); vr1[i] = *(const v2u*)(vb_ + 32 * D + voff); } } while (0)
        SCAN_LOAD(0);
        for (int c = 0; c < NCH; ++c) {
#pragma unroll
            for (int i = 1; i < 8; ++i) { l0[i] += l0[i - 1]; l1[i] += l1[i - 1]; }
            float t0[4], t1[4];
#pragma unroll
            for (int f = 0; f < 4; ++f) { t0[f] = __shfl(l0[7], fr + 16 * f); t1[f] = __shfl(l1[7], fr + 16 * f); }
            const float rr = (t0[0] + t0[1]) + (t0[2] + t0[3]);
            float pre0 = 0.f, pre1 = rr;
#pragma unroll
            for (int f = 0; f < 3; ++f) if (f < fq) { pre0 += t0[f]; pre1 += t1[f]; }
            const float bl = rr + ((t1[0] + t1[1]) + (t1[2] + t1[3]));
            v4u a0, a1;
            a0.x = pk2(k0[0] * clamp_exp(rr - (pre0 + l0[0])), k0[1] * clamp_exp(rr - (pre0 + l0[1])));
            a0.y = pk2(k0[2] * clamp_exp(rr - (pre0 + l0[2])), k0[3] * clamp_exp(rr - (pre0 + l0[3])));
            a0.z = pk2(k0[4] * clamp_exp(rr - (pre0 + l0[4])), k0[5] * clamp_exp(rr - (pre0 + l0[5])));
            a0.w = pk2(k0[6] * clamp_exp(rr - (pre0 + l0[6])), k0[7] * clamp_exp(rr - (pre0 + l0[7])));
            a1.x = pk2(k1[0] * clamp_exp(rr - (pre1 + l1[0])), k1[1] * clamp_exp(rr - (pre1 + l1[1])));
            a1.y = pk2(k1[2] * clamp_exp(rr - (pre1 + l1[2])), k1[3] * clamp_exp(rr - (pre1 + l1[3])));
            a1.z = pk2(k1[4] * clamp_exp(rr - (pre1 + l1[4])), k1[5] * clamp_exp(rr - (pre1 + l1[5])));
            a1.w = pk2(k1[6] * clamp_exp(rr - (pre1 + l1[6])), k1[7] * clamp_exp(rr - (pre1 + l1[7])));
            const bf16x8 af0 = __builtin_bit_cast(bf16x8, a0), af1 = __builtin_bit_cast(bf16x8, a1);
            const float eRc = fast_exp(rr), dUc = fast_exp(bl - rr), dDc = fast_exp(bl);
            f32x4 er, du, dd;
#pragma unroll
            for (int j = 0; j < 4; ++j) { er[j] = __shfl(eRc, 4 * fq + j); du[j] = __shfl(dUc, 4 * fq + j); dd[j] = __shfl(dDc, 4 * fq + j); }
            v4u bf0[4], bf1[4];
#pragma unroll
            for (int vt = 0; vt < 4; ++vt) {
#define VSEL(r) ((vt & 1) ? ((vt >> 1) == 0 ? (r).x >> 16 : (r).y >> 16) : ((vt >> 1) == 0 ? (r).x & 0xffffu : (r).y & 0xffffu))
                bf0[vt].x = VSEL(vr0[0]) | (VSEL(vr0[1]) << 16); bf0[vt].y = VSEL(vr0[2]) | (VSEL(vr0[3]) << 16); bf0[vt].z = VSEL(vr0[4]) | (VSEL(vr0[5]) << 16); bf0[vt].w = VSEL(vr0[6]) | (VSEL(vr0[7]) << 16);
                bf1[vt].x = VSEL(vr1[0]) | (VSEL(vr1[1]) << 16); bf1[vt].y = VSEL(vr1[2]) | (VSEL(vr1[3]) << 16); bf1[vt].z = VSEL(vr1[4]) | (VSEL(vr1[5]) << 16); bf1[vt].w = VSEL(vr1[6]) | (VSEL(vr1[7]) << 16);
#undef VSEL
            }
            if (c + 1 < NCH) SCAN_LOAD(c + 1);
#pragma unroll
            for (int vt = 0; vt < 4; ++vt) {
                f32x4 u = __builtin_amdgcn_mfma_f32_16x16x32_bf16(af0, __builtin_bit_cast(bf16x8, bf0[vt]), (f32x4){0.f, 0.f, 0.f, 0.f}, 0, 0, 0);
                u = __builtin_amdgcn_mfma_f32_16x16x32_bf16(af1, __builtin_bit_cast(bf16x8, bf1[vt]), u, 0, 0, 0);
                const f32x4 sp = S[vt] * er;
                v2u w; w.x = pk2(sp[0], sp[1]); w.y = pk2(sp[2], sp[3]);
                *(v2u*)(STi + (size_t)c * V * K + (size_t)vt * 16) = w;
                S[vt] = S[vt] * dd + u * du;
            }
        }
#undef SCAN_LOAD
#pragma unroll
        for (int j = 0; j < 4; ++j) {
            float* o = A.s_out_prompt + ((size_t)(b * H + h) * K + 16 * ks + 4 * fq + j) * V + vq * 64 + 4 * fr;
            *(f32x4*)o = (f32x4){S[0][j], S[1][j], S[2][j], S[3][j]};
        }
    }
#if defined(EXP_SERIAL)
    __syncthreads();
    _Pragma("nounroll") for (int rep_t = 0; rep_t < REP_STREAM; ++rep_t)
    for (int n = wave;; n += NWAVES) {
        const int it = F.vcu + F.G * n;
        if (it >= NST) break;
#elif defined(EXP_SERIAL4)
    __syncthreads();
    for (int n = wave - 4; n >= 0; n += 4) {
        const int it = F.vcu + F.G * n;
        if (it >= NST) break;
#elif defined(EXP_STATIC)
    constexpr int NSW = NSI / 256;
    for (int n = wave - NSW; n >= 0; n += NWAVES - NSW) {
        const int it = F.vcu + F.G * n;
        if (it >= NST) break;
#else
    for (;;) {
        unsigned n = 0;
        if (lane == 0) n = __hip_atomic_fetch_add(A.queue, 1u, __ATOMIC_RELAXED, __HIP_MEMORY_SCOPE_AGENT);
        n = (unsigned)__builtin_amdgcn_readfirstlane((int)n);
        const int it = (int)n;
        if (it >= NST) break;
#endif
        const int vp = it % VP, h = (it / VP) % H, b = it / (VP * H), R0 = MP + b * TS;
        float a[10];
#pragma unroll
        for (int i = 0; i < 10; ++i) a[i] = 0.f;
#pragma unroll
        for (int m = 0; m < KPL; ++m) {
            const int kk = lane + 64 * m, col = h * K + kk;
            float bt[4], q[4], kx[4];
#pragma unroll
            for (int t = 0; t < 4; ++t) { bt[t] = A.LF[(size_t)(R0 + t) * LDLF + col]; q[t] = bf2f(A.QB[(size_t)(R0 + t) * LDQK + col]); kx[t] = bf2f(A.KB[(size_t)(R0 + t) * LDQK + col]); }
#pragma unroll
            for (int t = 1; t < 4; ++t) bt[t] += bt[t - 1];
            LAS float* vk = vec + kk * 12;
            vk[0] = fast_exp(bt[3]);
#pragma unroll
            for (int t = 0; t < 4; ++t) { vk[1 + t] = kx[t] * fast_exp(bt[3] - bt[t]); vk[5 + t] = q[t] * fast_exp(bt[t]); }
#pragma unroll
            for (int t = 0; t < 4; ++t)
#pragma unroll
                for (int s = 0; s <= t; ++s) a[t * (t + 1) / 2 + s] += q[t] * kx[s] * fast_exp(bt[t] - bt[s]);
        }
#pragma unroll
        for (int i = 0; i < 10; ++i) a[i] = wave_sum(a[i]);
        const int v4 = lane % LPR, rh = lane / LPR, vc = h * V + vp * VWS + 4 * v4;
        float vs[4][4], o[4][4];
#pragma unroll
        for (int s = 0; s < 4; ++s) {
            const v2u raw = *(const v2u*)(A.VB + (size_t)(R0 + s) * D + vc); vs[s][0] = bflo(raw.x); vs[s][1] = bfhi(raw.x); vs[s][2] = bflo(raw.y); vs[s][3] = bfhi(raw.y);
#pragma unroll
            for (int e = 0; e < 4; ++e) o[s][e] = 0.f;
        }
        LDS_WAIT(); asm volatile("" ::: "memory");
        const float* sin = A.s_in + (size_t)(b * H + h) * K * V;
        float* sout = A.s_out_sample + (size_t)(b * H + h) * K * V;
        const int soff = rh * V + vp * VWS + 4 * v4;
        for (int kr = 0; kr < K; kr += UN * RPW) {
            f32x4 sv[UN];
#pragma unroll
            for (int u = 0; u < UN; ++u) sv[u] = *(const f32x4*)(sin + (size_t)(kr + u * RPW) * V + soff);
#pragma unroll
            for (int u = 0; u < UN; ++u) {
                const LAS f32x4* vk = (const LAS f32x4*)(vec + (kr + u * RPW + rh) * 12);
                const f32x4 c0 = vk[0], c1 = vk[1], c2 = vk[2];
                f32x4 sn;
#pragma unroll
                for (int e = 0; e < 4; ++e) {
                    const float s0 = sv[u][e];
                    sn[e] = c0[0] * s0 + c0[1] * vs[0][e] + c0[2] * vs[1][e] + c0[3] * vs[2][e] + c1[0] * vs[3][e];
                    o[0][e] += c1[1] * s0; o[1][e] += c1[2] * s0; o[2][e] += c1[3] * s0; o[3][e] += c2[0] * s0;
                }
                *(f32x4*)(sout + (size_t)(kr + u * RPW) * V + soff) = sn;
            }
        }
#pragma unroll
        for (int t = 0; t < 4; ++t) {
            f32x4 ov;
#pragma unroll
            for (int e = 0; e < 4; ++e) { float x = o[t][e];
                if constexpr (RPW == 2) x += __shfl_xor(x, 32);
#pragma unroll
                for (int s = 0; s <= t; ++s) x += a[t * (t + 1) / 2 + s] * vs[s][e];
                ov[e] = x; }
            if (rh == 0) *(f32x4*)(A.ORAW + (size_t)(R0 - MP + t) * D + vc) = ov;
        }
        asm volatile("" ::: "memory");
    }
}

template <bool GLA> __device__ __forceinline__ void rec_pass_b(Frame& F, const RecArgs& A) {
    typedef RecCfg<GLA> C; constexpr int K = C::K, V = C::V, H = C::H, SSEG = C::SSEG, L = C::L, KP = C::KP, SP = C::SP, VTW = (V / 16) / 8, KS = K / 32;
    LAS bf16* Qh = (LAS bf16*)F.lds;
    LAS bf16* Kh = Qh + CH * KP;
    LAS bf16* P = Kh + CH * KP;
    LAS bf16* Vt = P + CH * SP;
    LAS float* segtot = (LAS float*)(Vt + V * SP);
    LAS float* part = segtot + SSEG * K;
    const int tid = F.tid, lane = F.lane, wave = F.wave, fr = lane & 15, fq = lane >> 4;
    const int k = tid % K, sg = tid / K;
    for (int r = F.vcu * NWAVES + wave; r < MS; r += F.G * NWAVES) {
        f32x4 v[8]; row_load(A.ORAW + (size_t)r * D, lane, v);
        float rs[8];
#pragma unroll
        for (int j = 0; j < 8; ++j) rs[j] = (v[j][0] * v[j][0] + v[j][1] * v[j][1]) + (v[j][2] * v[j][2] + v[j][3] * v[j][3]);
        if constexpr (GLA) {
#pragma unroll
            for (int p = 0; p < 4; ++p) { const float t = wave_sum(rs[2 * p] + rs[2 * p + 1]); rs[2 * p] = t; rs[2 * p + 1] = t; }
        } else {
#pragma unroll
            for (int j = 0; j < 8; ++j) { float t = rs[j];
#pragma unroll
                for (int o = 1; o < 32; o <<= 1) t += __shfl_xor(t, o);
                rs[j] = t; }
        }
        const bf16* grow = A.GB + (size_t)(MP + r) * D; GAS v2u* o8 = (GAS v2u*)(A.O + (size_t)(MP + r) * D) + lane;
#pragma unroll
        for (int j = 0; j < 8; ++j) {
            const float rstd = 1.0f / sqrtf(rs[j] * (1.0f / V) + LN_EPS);
            const f32x4 nw = *((const GAS f32x4*)A.normw + lane + 64 * j);
            const v2u graw = *((const GAS v2u*)grow + lane + 64 * j);
            const f32x4 gt = (f32x4){bflo(graw.x), bfhi(graw.x), bflo(graw.y), bfhi(graw.y)};
            const f32x4 x = v[j] * rstd * nw * gt;
            v2u w; w.x = pk2(x[0], x[1]); w.y = pk2(x[2], x[3]); o8[64 * j] = w;
        }
    }
#define BAR_LDS() do { asm volatile("s_waitcnt lgkmcnt(0)" ::: "memory"); __builtin_amdgcn_s_barrier(); asm volatile("" ::: "memory"); } while (0)
    float lfr[L]; unsigned short qr[L], kr[L]; v4u vraw[V / 64];
#define PB_LOAD(it_) do { const int h_ = (it_) % H, c_ = ((it_) / H) % NCH, b_ = (it_) / (H * NCH), R_ = b_ * SEQ + c_ * CH; \
        _Pragma("unroll") for (int i = 0; i < V / 64; ++i) vraw[i] = *(const v4u*)(A.VB + (size_t)(R_ + (tid & 63)) * D + h_ * V + (wave + 8 * i) * 8); \
        const float* lfb_ = A.LF + (size_t)(R_ + sg * L) * C::LDLF + h_ * K + k; const bf16* qb_ = A.QB + (size_t)(R_ + sg * L) * C::LDQK + h_ * K + k; const bf16* kb_ = A.KB + (size_t)(R_ + sg * L) * C::LDQK + h_ * K + k; \
        _Pragma("unroll") for (int i = 0; i < L; ++i) { lfr[i] = lfb_[(size_t)i * C::LDLF]; qr[i] = qb_[(size_t)i * C::LDQK]; kr[i] = kb_[(size_t)i * C::LDQK]; } } while (0)
    if constexpr (!GLA) { if (F.vcu < NBP * NCH * H) PB_LOAD(F.vcu); }
    for (int it = F.vcu; it < NBP * NCH * H; it += F.G) {
        const int h = it % H, c = (it / H) % NCH, b = it / (H * NCH), R0 = b * SEQ + c * CH;
        if constexpr (GLA) PB_LOAD(it);
#pragma unroll
        for (int i = 0; i < V / 64; ++i) {
            const int s = tid & 63, v0 = (wave + 8 * i) * 8; const v4u raw = vraw[i];
            Vt[(v0 + 0) * SP + s] = (bf16)(raw.x & 0xffffu); Vt[(v0 + 1) * SP + s] = (bf16)(raw.x >> 16);
            Vt[(v0 + 2) * SP + s] = (bf16)(raw.y & 0xffffu); Vt[(v0 + 3) * SP + s] = (bf16)(raw.y >> 16);
            Vt[(v0 + 4) * SP + s] = (bf16)(raw.z & 0xffffu); Vt[(v0 + 5) * SP + s] = (bf16)(raw.z >> 16);
            Vt[(v0 + 6) * SP + s] = (bf16)(raw.w & 0xffffu); Vt[(v0 + 7) * SP + s] = (bf16)(raw.w >> 16);
        }
        {
#pragma unroll
            for (int i = 1; i < L; ++i) lfr[i] += lfr[i - 1];
            segtot[sg * K + k] = lfr[L - 1];
            BAR_LDS();
            float pre = 0.f, rr = 0.f;
#pragma unroll
            for (int s2 = 0; s2 < SSEG; ++s2) { const float t = segtot[s2 * K + k]; if (s2 < sg) pre += t; if (s2 < SSEG / 2) rr += t; }
#pragma unroll
            for (int i = 0; i < L; ++i) {
                const int s = sg * L + i;
                const float bb = pre + lfr[i];
                Qh[s * KP + k] = (bf16)f2bf(bf2f(qr[i]) * clamp_exp(bb - rr));
                Kh[s * KP + k] = (bf16)f2bf(bf2f(kr[i]) * clamp_exp(rr - bb));
            }
        }
        if constexpr (!GLA) { if (it + F.G < NBP * NCH * H) PB_LOAD(it + F.G); }
        BAR_LDS();
#pragma unroll
        for (int i = 0; i < 2; ++i) {
            const int tile = wave * 2 + i, st = tile >> 2, tt = tile & 3;
            f32x4 a4 = (f32x4){0.f, 0.f, 0.f, 0.f};
            if (st <= tt) {
#pragma unroll
                for (int ks = 0; ks < KS; ++ks) {
                    const bf16x8 a = *(const LAS bf16x8*)(Kh + (16 * st + fr) * KP + 32 * ks + 8 * fq);
                    const bf16x8 bq = *(const LAS bf16x8*)(Qh + (16 * tt + fr) * KP + 32 * ks + 8 * fq);
                    a4 = __builtin_amdgcn_mfma_f32_16x16x32_bf16(a, bq, a4, 0, 0, 0);
                }
                const int t = 16 * tt + fr;
#pragma unroll
                for (int j = 0; j < 4; ++j) if (16 * st + 4 * fq + j > t) a4[j] = 0.f;
            }
            v2u w; w.x = pk2(a4[0], a4[1]); w.y = pk2(a4[2], a4[3]);
            *(LAS v2u*)(P + (16 * tt + fr) * SP + 16 * st + 4 * fq) = w;
        }
        BAR_LDS();
        const bf16* STi = A.ST + (size_t)((b * H + h) * NCH + c) * V * K;
        f32x4 acc[VTW][4];
        float ssq[4] = {0.f, 0.f, 0.f, 0.f};
#pragma unroll
        for (int iv = 0; iv < VTW; ++iv) {
            const int vt = wave * VTW + iv;
#pragma unroll
            for (int tt = 0; tt < 4; ++tt) acc[iv][tt] = (f32x4){0.f, 0.f, 0.f, 0.f};
#pragma unroll
            for (int ks = 0; ks < 2; ++ks) {
                const bf16x8 a = *(const LAS bf16x8*)(Vt + (16 * vt + fr) * SP + 32 * ks + 8 * fq);
#pragma unroll
                for (int tt = 0; tt < 4; ++tt) {
                    const bf16x8 bp = *(const LAS bf16x8*)(P + (16 * tt + fr) * SP + 32 * ks + 8 * fq);
                    acc[iv][tt] = __builtin_amdgcn_mfma_f32_16x16x32_bf16(a, bp, acc[iv][tt], 0, 0, 0);
                }
            }
#pragma unroll
            for (int ks = 0; ks < KS; ++ks) {
                const bf16x8 a = *(const bf16x8*)(STi + ((size_t)(2 * ks + (fq >> 1)) * V + 16 * vt + fr) * 16 + 8 * (fq & 1));
#pragma unroll
                for (int tt = 0; tt < 4; ++tt) {
                    const bf16x8 bq = *(const LAS bf16x8*)(Qh + (16 * tt + fr) * KP + 32 * ks + 8 * fq);
                    acc[iv][tt] = __builtin_amdgcn_mfma_f32_16x16x32_bf16(a, bq, acc[iv][tt], 0, 0, 0);
                }
            }
#pragma unroll
            for (int tt = 0; tt < 4; ++tt) { const f32x4 x = acc[iv][tt]; ssq[tt] += (x[0] * x[0] + x[1] * x[1]) + (x[2] * x[2] + x[3] * x[3]); }
            asm volatile("" ::: "memory");
        }
#pragma unroll
        for (int tt = 0; tt < 4; ++tt) { float s = ssq[tt]; s += __shfl_xor(s, 16); s += __shfl_xor(s, 32); if (fq == 0) part[wave * 64 + 16 * tt + fr] = s; }
        BAR_LDS();
#pragma unroll
        for (int tt = 0; tt < 4; ++tt) {
            const int t = 16 * tt + fr; float tot = 0.f;
#pragma unroll
            for (int w = 0; w < 8; ++w) tot += part[w * 64 + t];
            const float rstd = 1.0f / sqrtf(tot * (1.0f / V) + LN_EPS);
#pragma unroll
            for (int iv = 0; iv < VTW; ++iv) {
                const int v0 = 16 * (wave * VTW + iv) + 4 * fq;
                const f32x4 nw = *(const f32x4*)(A.normw + h * V + v0);
                const v2u graw = *(const v2u*)(A.GB + (size_t)(R0 + t) * D + h * V + v0);
                const f32x4 gt = (f32x4){bflo(graw.x), bfhi(graw.x), bflo(graw.y), bfhi(graw.y)};
                const f32x4 r = acc[iv][tt] * rstd * nw * gt;
                v2u w; w.x = pk2(r[0], r[1]); w.y = pk2(r[2], r[3]);
                *(v2u*)(A.O + (size_t)(R0 + t) * D + h * V + v0) = w;
            }
        }
        BAR_LDS();
    }
#undef BAR_LDS
#undef PB_LOAD
}

constexpr int NPHASE = 3 + 8 * DEPTH;
#ifndef REP_G
#define REP_G 1
#endif
#ifndef REP_R
#define REP_R 1
#endif
#ifndef REP_L
#define REP_L 1
#endif
#ifndef REP_P
#define REP_P 1
#endif
#define REPEAT(n) _Pragma("nounroll") for (int rep_ = 0; rep_ < (n); ++rep_)
__device__ __forceinline__ RecArgs rec_args_hg(const Frame& F, int j) {
    RecArgs ra; ra.queue = (unsigned*)F.ws + CW_Q + 64 * (2 * j);
    ra.QB = (const bf16*)(F.ws + WS_QB); ra.KB = (const bf16*)(F.ws + WS_KB); ra.VB = (const bf16*)(F.ws + WS_VB); ra.GB = (const bf16*)(F.ws + WS_GB); ra.LF = (const float*)(F.ws + WS_LF);
    ra.O = (bf16*)(F.ws + WS_O); ra.ST = (bf16*)(F.ws + WS_ST); ra.ORAW = (float*)(F.ws + WS_ORAW);
    ra.normw = F.ka->in[12] + (size_t)j * D;
    ra.s_in = F.ka->in[2] + (size_t)j * NBS * HG_H * HG_K * HG_V; ra.s_out_sample = F.out + O_HGS + (size_t)j * NBS * HG_H * HG_K * HG_V; ra.s_out_prompt = F.out + O_HGP + (size_t)j * NBP * HG_H * HG_K * HG_V;
    return ra;
}
__device__ __forceinline__ RecArgs rec_args_gla(const Frame& F, int j) {
    RecArgs ra; ra.queue = (unsigned*)F.ws + CW_Q + 64 * (2 * j + 1);
    ra.QB = (const bf16*)(F.ws + WS_QB); ra.KB = (const bf16*)(F.ws + WS_KB); ra.VB = (const bf16*)(F.ws + WS_VB); ra.GB = (const bf16*)(F.ws + WS_GB); ra.LF = (const float*)(F.ws + WS_LF);
    ra.O = (bf16*)(F.ws + WS_O); ra.ST = (bf16*)(F.ws + WS_ST); ra.ORAW = (float*)(F.ws + WS_ORAW);
    ra.normw = F.ka->in[17] + (size_t)j * D;
    ra.s_in = F.ka->in[3] + (size_t)j * NBS * GL_H * GL_K * GL_V; ra.s_out_sample = F.out + O_GLS + (size_t)j * NBS * GL_H * GL_K * GL_V; ra.s_out_prompt = F.out + O_GLP + (size_t)j * NBP * GL_H * GL_K * GL_V;
    return ra;
}
__global__ void __launch_bounds__(NT, 2) fwd_kernel(Args args) {
    const int lo = args.ph_lo, hi = args.ph_hi;
    {
        Frame F = mk_frame();
        if (F.tid < 32) F.MISC[F.tid] = 0u;
        __syncthreads();
        if (!MK_PER_PHASE) (void)xcd_barrier_post((unsigned*)F.ws + CW_BAR, F.MISC);
    }
#define IN(k) (lo <= (k) && (k) < hi)
#define SEAM(k) do { if (IN(k) && IN((k) + 1)) { Frame Fb = mk_frame(); XcdBarrier bar; bar.bar = (unsigned*)Fb.ws + CW_BAR; bar.x = xb_xcc_id(); bar.st = Fb.MISC; xcd_barrier(bar); } } while (0)

    if (IN(0)) REPEAT(REP_P) { Frame F = mk_frame(); phase_p0(F); } SEAM(0);
    if (IN(1)) REPEAT(REP_P) { Frame F = mk_frame(); phase_p1(F); } SEAM(1);
    if (IN(2)) REPEAT(REP_P) { Frame F = mk_frame(); phase_p2(F); } SEAM(2);

#pragma nounroll
    for (int l = 0; l < DEPTH; ++l) {
        const int p0 = 3 + 8 * l, j = l >> 1;
        if ((l & 1) == 0) {
            if (IN(p0)) REPEAT(REP_G) {
                Frame F = mk_frame();
                pg8::GemmX g{(const bf16*)(F.ws + WS_H), (const bf16*)(F.ws + WS_H) + (size_t)MP * D, (const bf16*)(F.ws + WS_HGWI) + (size_t)j * 8192 * D, 8192, D}; pg8::StaticOrder S; S.init(MP, 8192, F.G, F.bx);
                EpiHgIn E{(bf16*)(F.ws + WS_QB), (float*)(F.ws + WS_LF), (const float*)(F.ws + WS_LB) + j * D};
                pg8::gemm_phase_x<EpiHgIn, pg8::StaticOrder>(F.lds, g, S, E);
            }
            SEAM(p0);
            if (IN(p0 + 1)) REPEAT(REP_R) { Frame F = mk_frame(); const RecArgs ra = rec_args_hg(F, j); rec_pass_a<false>(F, ra); }
            SEAM(p0 + 1);
            if (IN(p0 + 2)) REPEAT(REP_R) { Frame F = mk_frame(); const RecArgs ra = rec_args_hg(F, j); rec_pass_b<false>(F, ra); }
            SEAM(p0 + 2);
            if (IN(p0 + 3)) REPEAT(REP_G) {
                Frame F = mk_frame();
                pg8::GemmX g{(const bf16*)(F.ws + WS_O), (const bf16*)(F.ws + WS_O) + (size_t)MP * D, (const bf16*)(F.ws + WS_HGWO) + (size_t)j * D * D, D, D}; pg8::StaticOrder S; S.init(MP, D, F.G, F.bx);
                EpiRes E{(const float*)(F.ws + WS_X), (float*)(F.ws + WS_Z), (const float*)(F.ws + WS_MOD) + (size_t)(l * 6 + 2) * D};
                pg8::gemm_phase_x<EpiRes, pg8::StaticOrder>(F.lds, g, S, E);
            }
            SEAM(p0 + 3);
        } else {
            if (IN(p0)) REPEAT(REP_G) {
                Frame F = mk_frame();
                pg8::GemmX g{(const bf16*)(F.ws + WS_H), (const bf16*)(F.ws + WS_H) + (size_t)MP * D, (const bf16*)(F.ws + WS_GLWI) + (size_t)j * GL_INP * D, GL_INP, D}; pg8::StaticOrder S; S.init(MP, GL_INP, F.G, F.bx);
                EpiGlaIn E{(bf16*)(F.ws + WS_QB)};
                pg8::gemm_phase_x<EpiGlaIn, pg8::StaticOrder>(F.lds, g, S, E);
            }
            SEAM(p0);
            if (IN(p0 + 1)) REPEAT(REP_R) { Frame F = mk_frame(); const RecArgs ra = rec_args_gla(F, j); rec_pass_a<true>(F, ra); }
            SEAM(p0 + 1);
            if (IN(p0 + 2)) REPEAT(REP_R) { Frame F = mk_frame(); const RecArgs ra = rec_args_gla(F, j); rec_pass_b<true>(F, ra); }
            SEAM(p0 + 2);
            if (IN(p0 + 3)) REPEAT(REP_G) {
                Frame F = mk_frame();
                pg8::GemmX g{(const bf16*)(F.ws + WS_O), (const bf16*)(F.ws + WS_O) + (size_t)MP * D, (const bf16*)(F.ws + WS_GLWO) + (size_t)j * D * D, D, D}; pg8::StaticOrder S; S.init(MP, D, F.G, F.bx);
                EpiRes E{(const float*)(F.ws + WS_X), (float*)(F.ws + WS_Z), (const float*)(F.ws + WS_MOD) + (size_t)(l * 6 + 2) * D};
                pg8::gemm_phase_x<EpiRes, pg8::StaticOrder>(F.lds, g, S, E);
            }
            SEAM(p0 + 3);
        }
        if (IN(p0 + 4)) REPEAT(REP_L) { Frame F = mk_frame(); phase_ln<false>(F, F.ka->in[8] + (size_t)(l * 2 + 0) * D, F.ka->in[9] + (size_t)(l * 2 + 0) * D, (l * 6 + 4) * D, (l * 6 + 3) * D, false, 0); }
        SEAM(p0 + 4);
        if (IN(p0 + 5)) REPEAT(REP_G) {
            Frame F = mk_frame();
            pg8::GemmX g{(const bf16*)(F.ws + WS_H), (const bf16*)(F.ws + WS_H) + (size_t)MP * D, (const bf16*)(F.ws + WS_WUP) + (size_t)l * DFF * D, DFF, D}; pg8::StaticOrder S; S.init(MP, DFF, F.G, F.bx);
            EpiUp E{(bf16*)(F.ws + WS_U)};
            pg8::gemm_phase_x<EpiUp, pg8::StaticOrder>(F.lds, g, S, E);
        }
        SEAM(p0 + 5);
        if (IN(p0 + 6)) REPEAT(REP_G) {
            Frame F = mk_frame();
            pg8::GemmX g{(const bf16*)(F.ws + WS_U), (const bf16*)(F.ws + WS_U) + (size_t)MP * DFF, (const bf16*)(F.ws + WS_WDN) + (size_t)l * D * DFF, D, DFF}; pg8::StaticOrder S; S.init(MP, D, F.G, F.bx);
            EpiRes E{(const float*)(F.ws + WS_X), (float*)(F.ws + WS_Z), (const float*)(F.ws + WS_MOD) + (size_t)(l * 6 + 5) * D};
            pg8::gemm_phase_x<EpiRes, pg8::StaticOrder>(F.lds, g, S, E);
        }
        SEAM(p0 + 6);
        if (IN(p0 + 7)) REPEAT(REP_L) { Frame F = mk_frame();
            if ((l & 1) == 0) phase_ln<true>(F, F.ka->in[8] + (size_t)(l * 2 + 1) * D, F.ka->in[9] + (size_t)(l * 2 + 1) * D, ((l + 1) * 6 + 1) * D, ((l + 1) * 6 + 0) * D, false, j);
            else phase_ln<false>(F, F.ka->in[8] + (size_t)(l * 2 + 1) * D, F.ka->in[9] + (size_t)(l * 2 + 1) * D, ((l + 1) * 6 + 1) * D, ((l + 1) * 6 + 0) * D, l == DEPTH - 1, 0); }
        if (l + 1 < DEPTH) SEAM(p0 + 7);
    }
#undef IN
#undef SEAM
}

extern "C" void kernel_launch(void* const* d_in, const int* in_sizes, int n_in, void* d_out, int out_size, void* d_ws, size_t ws_size, hipStream_t stream) {
    static int grid = 0;
    if (grid == 0) {
        if (n_in != 21 || (size_t)out_size != O_END || ws_size < WS_END) { fprintf(stderr, "kernel_launch: unexpected problem (n_in %d, out %d, ws %zu; need out %zu, ws >= %zu); nothing launched\n", n_in, out_size, ws_size, (size_t)O_END, (size_t)WS_END); grid = -1; return; }
        int dev = 0, cus = 0, per_cu = 0;
        if (hipGetDevice(&dev) != hipSuccess || hipDeviceGetAttribute(&cus, hipDeviceAttributeMultiprocessorCount, dev) != hipSuccess) { grid = -1; return; }
        if (hipFuncSetAttribute((const void*)fwd_kernel, hipFuncAttributeMaxDynamicSharedMemorySize, LDS_BYTES) != hipSuccess) { fprintf(stderr, "kernel_launch: hipFuncSetAttribute failed\n"); grid = -1; return; }
        if (hipOccupancyMaxActiveBlocksPerMultiprocessor(&per_cu, (const void*)fwd_kernel, NT, LDS_BYTES) != hipSuccess || per_cu < 1) fprintf(stderr, "kernel_launch: occupancy query says %d\n", per_cu);
        (void)hipGetLastError();
        grid = cus;
    }
    if (grid < 0) return;
    if (hipMemsetAsync((char*)d_ws + WS_CTL, 0, CTL_ZERO_BYTES, stream) != hipSuccess) return;
    Args a{};
    for (int i = 0; i < 21; ++i) a.in[i] = (const float*)d_in[i];
    a.out = (float*)d_out; a.ws = (unsigned char*)d_ws;
#if MK_PER_PHASE
    for (int p = 0; p < NPHASE; ++p) { a.ph_lo = p; a.ph_hi = p + 1; hipLaunchKernelGGL(fwd_kernel, dim3(grid), dim3(NT), LDS_BYTES, stream, a); }
#elif defined(PROBE_PHASES)
    {
        const int dup[] = {PROBE_PHASES}; const int nd = (int)(sizeof(dup) / sizeof(dup[0])); int lo = 0;
        for (int i = 0; i <= nd; ++i) {
            const int hi = i < nd ? dup[i] + 1 : NPHASE;
            if (i > 0) (void)hipMemsetAsync((char*)d_ws + WS_CTL, 0, CTL_ZERO_BYTES, stream);
            a.ph_lo = lo; a.ph_hi = hi; hipLaunchKernelGGL(fwd_kernel, dim3(grid), dim3(NT), LDS_BYTES, stream, a);
            if (i < nd) { (void)hipMemsetAsync((char*)d_ws + WS_CTL, 0, CTL_ZERO_BYTES, stream); a.ph_lo = dup[i]; a.ph_hi = dup[i] + 1; hipLaunchKernelGGL(fwd_kernel, dim3(grid), dim3(NT), LDS_BYTES, stream, a); }
            lo = hi;
        }
    }
#else
    a.ph_lo = 0; a.ph_hi = NPHASE;
    hipLaunchKernelGGL(fwd_kernel, dim3(grid), dim3(NT), LDS_BYTES, stream, a);
#endif
    const hipError_t le = hipPeekAtLastError();
    if (le != hipSuccess) fprintf(stderr, "kernel_launch: launch failed: %s\n", hipGetErrorName(le));
}
```
